# Optimizing an MI355X kernel written in HIP

```python
import math
import jax, jax.numpy as jnp
from jax import lax
import numpy as np

D_MODEL = 2048
BATCH = 1
SEQ = 16384
DEPTH = 1

N_META = 16
MIX_WIDTH = D_MODEL
ATT_WIDTH = MIX_WIDTH // 2
SSM_WIDTH = MIX_WIDTH - ATT_WIDTH
ATT_HEAD_DIM = 64
ATT_V_DIM = 2 * ATT_HEAD_DIM
ATT_HEADS = ATT_WIDTH // ATT_V_DIM
QK_WIDTH = ATT_HEADS * 2 * ATT_HEAD_DIM
IN_WIDTH = 2 * QK_WIDTH + ATT_WIDTH + SSM_WIDTH
SSM_GROUP = 16
SSM_GROUPS = SSM_WIDTH // SSM_GROUP
SSM_STATE = 64
N_BUCKETS = 32
MAX_DISTANCE = 128
Q_BLOCK = 128
N_EXPERTS = 64
TOP_K = 8
N_EXPERT_GROUPS = 8
TOPK_GROUPS = 4
EXPERT_HIDDEN = 512
SHARED_HIDDEN = 512
ROUTED_SCALE = 2.5
MOE_BLOCK = 128
EPS = 1e-6

kernel_name = "hymba_diffattn_s5_moe_encoder"


def rms_norm(x, gain):
    xf = x.astype(jnp.float32)
    y = xf * lax.rsqrt(jnp.mean(xf * xf, axis=-1, keepdims=True) + EPS)
    return (y * gain.astype(jnp.float32)).astype(x.dtype)


def t5_bucket(rel):
    half = N_BUCKETS // 2
    exact = half // 2
    side = jnp.where(rel > 0, half, 0)
    n = jnp.abs(rel)
    nf = jnp.maximum(n, 1).astype(jnp.float32)
    large = exact + (jnp.log(nf / exact) / math.log(MAX_DISTANCE / exact) * (half - exact)).astype(jnp.int32)
    large = jnp.minimum(large, half - 1)
    return side + jnp.where(n < exact, n, large)


def diff_attention(q, k, v, rel_bias, lam, lambda_init, subln):
    b, l = q.shape[0], q.shape[1]
    n_qb = -(-l // Q_BLOCK)
    l_pad = n_qb * Q_BLOCK
    qf = jnp.pad(q.astype(jnp.float32), ((0, 0), (0, l_pad - l), (0, 0), (0, 0), (0, 0)))
    qf = qf.reshape(b, n_qb, Q_BLOCK, ATT_HEADS, 2, ATT_HEAD_DIM).transpose(1, 4, 0, 3, 2, 5)
    kf = k.astype(jnp.float32).transpose(3, 0, 2, 1, 4)
    vf = v.astype(jnp.float32).transpose(0, 2, 1, 3)
    kpos = jnp.arange(l, dtype=jnp.int32)
    scale = ATT_HEAD_DIM ** -0.5
    table = rel_bias.astype(jnp.float32)

    def block(args):
        qb, start = args
        qpos = start + jnp.arange(Q_BLOCK, dtype=jnp.int32)
        bucket = t5_bucket(kpos[None, :] - qpos[:, None])
        bias = jnp.transpose(table[bucket], (2, 0, 1))
        s = jnp.einsum('cbhqd,cbhkd->cbhqk', qb, kf) * scale + bias
        p = jax.nn.softmax(s, axis=-1)
        a = p[0] - lam * p[1]
        return jnp.einsum('bhqk,bhkd->bhqd', a, vf)

    starts = jnp.arange(n_qb, dtype=jnp.int32) * Q_BLOCK
    out = lax.map(block, (qf, starts))
    out = out.transpose(1, 0, 3, 2, 4).reshape(b, l_pad, ATT_HEADS, ATT_V_DIM)[:, :l]
    out = rms_norm(out, subln) * (1.0 - lambda_init)
    return out.reshape(b, l, ATT_WIDTH)


def _complex_affine_combine(e1, e2):
    a1r, a1i, b1r, b1i = e1
    a2r, a2i, b2r, b2i = e2
    return (a2r * a1r - a2i * a1i,
            a2r * a1i + a2i * a1r,
            a2r * b1r - a2i * b1i + b2r,
            a2r * b1i + a2i * b1r + b2i)


def s5_scan(u, a_re, a_im, log_step, b_re, b_im, c_re, c_im, reverse):
    f32 = jnp.float32
    a_re = a_re.astype(f32)
    a_im = a_im.astype(f32)
    dt = jnp.exp(log_step.astype(f32))[:, None]
    decay = jnp.exp(a_re * dt)
    ab_re = decay * jnp.cos(a_im * dt)
    ab_im = decay * jnp.sin(a_im * dt)
    den = a_re * a_re + a_im * a_im
    zr = ab_re - 1.0
    f_re = (zr * a_re + ab_im * a_im) / den
    f_im = (ab_im * a_re - zr * a_im) / den
    b_re = b_re.astype(f32)
    b_im = b_im.astype(f32)
    bb_re = f_re[..., None] * b_re - f_im[..., None] * b_im
    bb_im = f_re[..., None] * b_im + f_im[..., None] * b_re
    bu_re = jnp.einsum('blgp,gnp->blgn', u, bb_re)
    bu_im = jnp.einsum('blgp,gnp->blgn', u, bb_im)
    a_full_re = jnp.broadcast_to(ab_re, bu_re.shape)
    a_full_im = jnp.broadcast_to(ab_im, bu_re.shape)
    _, _, s_re, s_im = lax.associative_scan(
        _complex_affine_combine, (a_full_re, a_full_im, bu_re, bu_im), axis=1, reverse=reverse)
    return (jnp.einsum('blgn,gpn->blgp', s_re, c_re.astype(f32))
            - jnp.einsum('blgn,gpn->blgp', s_im, c_im.astype(f32)))


def s5_mixer(u, a_re, a_im, log_step, b_re, b_im, c_re, c_im, d_skip, w_glu, b_glu):
    b, l = u.shape[0], u.shape[1]
    uf = u.astype(jnp.float32).reshape(b, l, SSM_GROUPS, SSM_GROUP)
    y = d_skip.astype(jnp.float32).reshape(SSM_GROUPS, SSM_GROUP) * uf
    y = y + s5_scan(uf, a_re[0], a_im[0], log_step[0], b_re[0], b_im[0], c_re[0], c_im[0], False)
    y = y + s5_scan(uf, a_re[1], a_im[1], log_step[1], b_re[1], b_im[1], c_re[1], c_im[1], True)
    y = jax.nn.gelu(y.reshape(b, l, SSM_WIDTH))
    gate = jax.nn.sigmoid(y @ w_glu.astype(jnp.float32) + b_glu.astype(jnp.float32))
    return (y * gate).astype(u.dtype)


def swiglu(x, w_gate, w_up, w_down):
    return (jax.nn.silu(x @ w_gate) * (x @ w_up)) @ w_down


def routed_moe(xn, router_w, router_bias, w_gate, w_up, w_down):
    b, l, d = xn.shape
    t = b * l
    xt = xn.reshape(t, d)
    scores = jax.nn.sigmoid(xt.astype(jnp.float32) @ router_w.astype(jnp.float32))
    choice = scores + router_bias.astype(jnp.float32)
    per_group = N_EXPERTS // N_EXPERT_GROUPS
    grp_score = lax.top_k(choice.reshape(t, N_EXPERT_GROUPS, per_group), 2)[0].sum(-1)
    _, top_groups = lax.top_k(grp_score, TOPK_GROUPS)
    gmask = jnp.any(top_groups[..., None] == jnp.arange(N_EXPERT_GROUPS), axis=1)
    emask = jnp.repeat(gmask, per_group, axis=1)
    _, idx = lax.top_k(jnp.where(emask, choice, -jnp.inf), TOP_K)
    wts = jnp.take_along_axis(scores, idx, axis=1)
    wts = wts / jnp.sum(wts, axis=-1, keepdims=True) * ROUTED_SCALE

    n_assign = t * TOP_K
    flat_e = idx.reshape(-1)
    flat_tok = jnp.repeat(jnp.arange(t, dtype=jnp.int32), TOP_K)
    flat_w = wts.reshape(-1)
    order = jnp.argsort(flat_e)
    se = flat_e[order]
    counts = jnp.bincount(flat_e, length=N_EXPERTS)
    starts = jnp.cumsum(counts) - counts
    padded = (counts + MOE_BLOCK - 1) // MOE_BLOCK * MOE_BLOCK
    pad_ends = jnp.cumsum(padded)
    pad_starts = pad_ends - padded
    dest = pad_starts[se] + jnp.arange(n_assign) - starts[se]
    n_blocks = -(-n_assign // MOE_BLOCK) + N_EXPERTS
    n_slots = n_blocks * MOE_BLOCK
    slot_tok = jnp.full((n_slots,), t, jnp.int32).at[dest].set(flat_tok[order])
    slot_w = jnp.zeros((n_slots,), jnp.float32).at[dest].set(flat_w[order])
    block_e = jnp.minimum(
        jnp.searchsorted(pad_ends, jnp.arange(n_blocks) * MOE_BLOCK, side='right'), N_EXPERTS - 1)

    x_pad = jnp.concatenate([xt, jnp.zeros((1, d), xt.dtype)], axis=0)

    def step(acc, inp):
        tok, wt, e = inp
        xb = x_pad[tok]
        yb = swiglu(xb, w_gate[e], w_up[e], w_down[e]).astype(jnp.float32) * wt[:, None]
        return acc.at[tok].add(yb), None

    acc0 = jnp.zeros((t + 1, d), jnp.float32)
    acc, _ = lax.scan(step, acc0, (slot_tok.reshape(n_blocks, MOE_BLOCK),
                                   slot_w.reshape(n_blocks, MOE_BLOCK), block_e))
    return acc[:t].reshape(b, l, d).astype(xn.dtype)


def setup_inputs(seed: int = 0) -> dict:
    key = jax.random.key(seed)
    ks = jax.random.split(key, 40)
    f32 = jnp.float32

    def nrm(k, shape, scale):
        return jax.random.normal(k, shape, f32) * scale

    n_idx = jnp.arange(SSM_STATE, dtype=f32)
    return {
        "x": nrm(ks[0], (BATCH, SEQ, D_MODEL), 1.0),
        "meta_tokens": nrm(ks[1], (N_META, D_MODEL), 1.0),
        "rel_bias": nrm(ks[2], (N_BUCKETS, ATT_HEADS), 0.1),
        "norm_mix": 1.0 + nrm(ks[3], (DEPTH, D_MODEL), 0.02),
        "w_in": nrm(ks[4], (DEPTH, D_MODEL, IN_WIDTH), D_MODEL ** -0.5),
        "q_norm": 1.0 + nrm(ks[5], (DEPTH, ATT_HEAD_DIM), 0.02),
        "k_norm": 1.0 + nrm(ks[6], (DEPTH, ATT_HEAD_DIM), 0.02),
        "lam_q1": nrm(ks[7], (DEPTH, ATT_HEAD_DIM), 0.1),
        "lam_k1": nrm(ks[8], (DEPTH, ATT_HEAD_DIM), 0.1),
        "lam_q2": nrm(ks[9], (DEPTH, ATT_HEAD_DIM), 0.1),
        "lam_k2": nrm(ks[10], (DEPTH, ATT_HEAD_DIM), 0.1),
        "subln": 1.0 + nrm(ks[11], (DEPTH, ATT_V_DIM), 0.02),
        "ssm_a_re": -0.5 + nrm(ks[12], (DEPTH, 2, SSM_GROUPS, SSM_STATE), 0.01),
        "ssm_a_im": math.pi * n_idx + nrm(ks[13], (DEPTH, 2, SSM_GROUPS, SSM_STATE), 0.01),
        "ssm_log_step": jax.random.uniform(ks[14], (DEPTH, 2, SSM_GROUPS), f32,
                                           math.log(1e-3), math.log(1e-1)),
        "ssm_b_re": nrm(ks[15], (DEPTH, 2, SSM_GROUPS, SSM_STATE, SSM_GROUP), (2 * SSM_GROUP) ** -0.5),
        "ssm_b_im": nrm(ks[16], (DEPTH, 2, SSM_GROUPS, SSM_STATE, SSM_GROUP), (2 * SSM_GROUP) ** -0.5),
        "ssm_c_re": nrm(ks[17], (DEPTH, 2, SSM_GROUPS, SSM_GROUP, SSM_STATE), SSM_STATE ** -0.5),
        "ssm_c_im": nrm(ks[18], (DEPTH, 2, SSM_GROUPS, SSM_GROUP, SSM_STATE), SSM_STATE ** -0.5),
        "ssm_d": nrm(ks[19], (DEPTH, SSM_WIDTH), 0.5),
        "w_glu": nrm(ks[20], (DEPTH, SSM_WIDTH, SSM_WIDTH), SSM_WIDTH ** -0.5),
        "b_glu": nrm(ks[21], (DEPTH, SSM_WIDTH), 0.01),
        "ssm_norm": 1.0 + nrm(ks[22], (DEPTH, SSM_WIDTH), 0.02),
        "w_out": nrm(ks[23], (DEPTH, MIX_WIDTH, D_MODEL), MIX_WIDTH ** -0.5),
        "norm_ffn": 1.0 + nrm(ks[24], (DEPTH, D_MODEL), 0.02),
        "router_w": nrm(ks[25], (DEPTH, D_MODEL, N_EXPERTS), D_MODEL ** -0.5),
        "router_bias": nrm(ks[26], (DEPTH, N_EXPERTS), 0.01),
        "w_gate": nrm(ks[27], (DEPTH, N_EXPERTS, D_MODEL, EXPERT_HIDDEN), D_MODEL ** -0.5),
        "w_up": nrm(ks[28], (DEPTH, N_EXPERTS, D_MODEL, EXPERT_HIDDEN), D_MODEL ** -0.5),
        "w_down": nrm(ks[29], (DEPTH, N_EXPERTS, EXPERT_HIDDEN, D_MODEL), EXPERT_HIDDEN ** -0.5),
        "shared_gate": nrm(ks[30], (DEPTH, D_MODEL, SHARED_HIDDEN), D_MODEL ** -0.5),
        "shared_up": nrm(ks[31], (DEPTH, D_MODEL, SHARED_HIDDEN), D_MODEL ** -0.5),
        "shared_down": nrm(ks[32], (DEPTH, SHARED_HIDDEN, D_MODEL), SHARED_HIDDEN ** -0.5),
    }


def reference(x, meta_tokens, rel_bias, norm_mix, w_in, q_norm, k_norm, lam_q1, lam_k1,
              lam_q2, lam_k2, subln, ssm_a_re, ssm_a_im, ssm_log_step, ssm_b_re, ssm_b_im,
              ssm_c_re, ssm_c_im, ssm_d, w_glu, b_glu, ssm_norm, w_out, norm_ffn, router_w,
              router_bias, w_gate, w_up, w_down, shared_gate, shared_up, shared_down):
    b = x.shape[0]
    meta = jnp.broadcast_to(meta_tokens.astype(x.dtype)[None], (b, N_META, D_MODEL))
    h = jnp.concatenate([meta, x], axis=1)
    l = h.shape[1]
    for i in range(DEPTH):
        hn = rms_norm(h, norm_mix[i])
        proj = hn @ w_in[i]
        q = proj[..., :QK_WIDTH].reshape(b, l, ATT_HEADS, 2, ATT_HEAD_DIM)
        k = proj[..., QK_WIDTH:2 * QK_WIDTH].reshape(b, l, ATT_HEADS, 2, ATT_HEAD_DIM)
        v = proj[..., 2 * QK_WIDTH:2 * QK_WIDTH + ATT_WIDTH].reshape(b, l, ATT_HEADS, ATT_V_DIM)
        u = proj[..., 2 * QK_WIDTH + ATT_WIDTH:]
        q = rms_norm(q, q_norm[i])
        k = rms_norm(k, k_norm[i])
        lambda_init = 0.8 - 0.6 * math.exp(-0.3 * i)
        lam = (jnp.exp(jnp.sum(lam_q1[i].astype(jnp.float32) * lam_k1[i].astype(jnp.float32)))
               - jnp.exp(jnp.sum(lam_q2[i].astype(jnp.float32) * lam_k2[i].astype(jnp.float32)))
               + lambda_init)
        att = diff_attention(q, k, v, rel_bias, lam, lambda_init, subln[i]).astype(h.dtype)
        ssm = s5_mixer(u, ssm_a_re[i], ssm_a_im[i], ssm_log_step[i], ssm_b_re[i], ssm_b_im[i],
                       ssm_c_re[i], ssm_c_im[i], ssm_d[i], w_glu[i], b_glu[i])
        ssm = rms_norm(ssm, ssm_norm[i]).astype(h.dtype)
        h = h + jnp.concatenate([att, ssm], axis=-1) @ w_out[i]
        hn = rms_norm(h, norm_ffn[i])
        h = (h + swiglu(hn, shared_gate[i], shared_up[i], shared_down[i])
             + routed_moe(hn, router_w[i], router_bias[i], w_gate[i], w_up[i], w_down[i]))
    return h[:, N_META:, :]
```

```cpp
#include <hip/hip_runtime.h>
#include <stdint.h>
#include <math.h>

typedef unsigned short bf16_t;
#define DEV __device__ __forceinline__

constexpr int T = 16384, NMETA = 16, LTOT = T + NMETA, DM = 2048;
constexpr int NH = 8, HD = 64, DV = 128, QKW = 1024, INW = 4096;
constexpr int NG = 64, GP = 16, NST = 64, SSMW = 1024;
constexpr int TC = 32, NCH = T / TC;
constexpr int NE = 64, TOPK = 8, EH = 512, SH = 512;
constexpr int KROWS = 16448;
constexpr int NSLOT = T * TOPK + NE * 256;
constexpr float EPS = 1e-6f;
constexpr float LOG2E = 1.4426950408889634f;
constexpr float C2 = 0.125f * LOG2E;
constexpr int LUTN = 183;

constexpr size_t MiB = 1u << 20;
constexpr size_t WS_CTL   = 0;
constexpr size_t WS_WSM   = 8 * MiB;
constexpr size_t WS_WDN   = 40 * MiB;
constexpr size_t WS_H     = 168 * MiB;
constexpr size_t WS_HS    = 296 * MiB;
constexpr size_t WS_H1    = 312 * MiB;
constexpr size_t WS_Y     = 456 * MiB;
constexpr size_t WS_WGU   = 456 * MiB;
constexpr size_t WS_HB    = 712 * MiB;
constexpr size_t WS_CAT   = 776 * MiB;
constexpr size_t WS_TAB   = 840 * MiB;
constexpr size_t WS_XB    = 904 * MiB;
constexpr size_t WS_UX    = 969 * MiB;
constexpr size_t WS_Q     = WS_H1;
constexpr size_t WS_K     = WS_H1 + 32 * MiB;
constexpr size_t WS_V     = WS_H1 + 65 * MiB;
constexpr size_t WS_OACC  = WS_H;
constexpr size_t WS_YF    = WS_H1;
constexpr size_t WS_YR    = WS_H1 + 64 * MiB;
constexpr size_t WS_YS    = WS_H + 32 * MiB;
constexpr size_t WS_TMP   = WS_H1;
constexpr size_t WS_END   = 1017 * MiB;

constexpr size_t C_CNT     = 0;
constexpr size_t C_OFF     = 1024;
constexpr size_t C_LAM     = 2048;
constexpr size_t C_LUT     = 4096;
constexpr size_t C_RSTDX   = 16384;
constexpr size_t C_RSTDS   = C_RSTDX + 16640 * 4;
constexpr size_t C_RSTDH   = C_RSTDS + 16384 * 4;
constexpr size_t C_UMETA   = C_RSTDH + 16384 * 4;
constexpr size_t C_SSMP    = 512 * 1024;
constexpr size_t WS_LOGIT  = WS_XB;
constexpr size_t C_IDX     = 2 * MiB;
constexpr size_t C_WTS     = C_IDX + 512 * 1024;
constexpr size_t C_POS     = C_WTS + 512 * 1024;
constexpr size_t C_STOK    = C_POS + 512 * 1024;
constexpr size_t C_SDST    = C_STOK + 640 * 1024;
constexpr size_t C_SW      = C_SDST + 640 * 1024;
static_assert(C_SW + NSLOT * 4 <= 8 * MiB, "ctl map");
static_assert(C_SSMP + (2 * 64 * 64 * 2 + 2 * 64 * 64 * 16 * 2) * 4 <= C_IDX, "ctl map");
static_assert(C_UMETA + 16 * 1024 * 4 <= C_SSMP, "ctl map");

DEV float bf2f(bf16_t b) { return __uint_as_float(((unsigned)b) << 16); }
DEV bf16_t f2bf(float f) { unsigned u = __float_as_uint(f); return (bf16_t)((u + 0x7fffu + ((u >> 16) & 1u)) >> 16); }
DEV float wave_sum(float v) {
#pragma unroll
    for (int o = 1; o < 64; o <<= 1) v += __shfl_xor(v, o);
    return v;
}
DEV float sigmoidf_(float x) { return 1.0f / (1.0f + __expf(-x)); }
DEV float gelu_tanh(float x) { const float u = 0.7978845608028654f * (x + 0.044715f * x * x * x); return 0.5f * x * (1.0f + tanhf(u)); }

struct In {
    const float *x, *meta, *rel_bias, *norm_mix, *w_in, *q_norm, *k_norm, *lam_q1, *lam_k1, *lam_q2, *lam_k2, *subln;
    const float *a_re, *a_im, *log_step, *b_re, *b_im, *c_re, *c_im, *ssm_d, *w_glu, *b_glu, *ssm_norm, *w_out, *norm_ffn;
    const float *router_w, *router_bias, *w_gate, *w_up, *w_down, *sh_gate, *sh_up, *sh_down;
};

__global__ void __launch_bounds__(256) k_prep_x(In in, unsigned char* ws) {
    const int wave = (blockIdx.x * 256 + threadIdx.x) >> 6, lane = threadIdx.x & 63;
    if (wave >= LTOT) return;
    const float* src = wave < T ? in.x + (size_t)wave * DM : in.meta + (size_t)(wave - T) * DM;
    bf16_t* dst = (bf16_t*)(ws + WS_XB) + (size_t)wave * DM;
    float ss = 0.f;
    for (int j = 0; j < DM / 256; ++j) {
        const float4 v = *(const float4*)(src + j * 256 + lane * 4);
        ss += v.x * v.x + v.y * v.y + v.z * v.z + v.w * v.w;
        ushort4 o; o.x = f2bf(v.x); o.y = f2bf(v.y); o.z = f2bf(v.z); o.w = f2bf(v.w);
        *(ushort4*)(dst + j * 256 + lane * 4) = o;
    }
    ss = wave_sum(ss);
    if (lane == 0) ((float*)(ws + WS_CTL + C_RSTDX))[wave] = rsqrtf(ss * (1.0f / DM) + EPS);
}

DEV int t5_bucket(int rel) {
    const int n = rel < 0 ? -rel : rel;
    int b;
    if (n < 8) b = n;
    else { const float nf = (float)n; int large = 8 + (int)(logf(nf / 8.0f) / 2.772588722239781f * 8.0f); b = large < 15 ? large : 15; }
    return (rel > 0 ? 16 : 0) + b;
}
__global__ void __launch_bounds__(256) k_tables(In in, unsigned char* ws) {
    const int tid = blockIdx.x * 256 + threadIdx.x, nthr = gridDim.x * 256;
    float* lut = (float*)(ws + WS_CTL + C_LUT);
    for (int i = tid; i < NH * LUTN; i += nthr) { const int h = i / LUTN, rel = i % LUTN - 91; lut[i] = in.rel_bias[t5_bucket(rel) * NH + h] * LOG2E; }
    if (tid == 0) {
        float s1 = 0.f, s2 = 0.f;
        for (int i = 0; i < HD; ++i) { s1 += in.lam_q1[i] * in.lam_k1[i]; s2 += in.lam_q2[i] * in.lam_k2[i]; }
        *(float*)(ws + WS_CTL + C_LAM) = expf(s1) - expf(s2) + 0.2f;
    }
    if (tid < NE) ((int*)(ws + WS_CTL + C_CNT))[tid] = 0;
    float* abar = (float*)(ws + WS_CTL + C_SSMP);
    float* bbar = abar + 2 * 64 * 64 * 2;
    for (int i = tid; i < 2 * NG * NST; i += nthr) {
        const int dg = i / NST;
        const float are = in.a_re[i], aim = in.a_im[i], dt = expf(in.log_step[dg]);
        const float decay = expf(are * dt); float sn, cs; sincosf(aim * dt, &sn, &cs);
        const float abr = decay * cs, abi = decay * sn, den = are * are + aim * aim, zr = abr - 1.0f;
        const float fre = (zr * are + abi * aim) / den, fim = (abi * are - zr * aim) / den;
        abar[i * 2] = abr; abar[i * 2 + 1] = abi;
        for (int p = 0; p < GP; ++p) { const float br = in.b_re[(size_t)i * GP + p], bi = in.b_im[(size_t)i * GP + p];
            bbar[((size_t)i * GP + p) * 2] = fre * br - fim * bi; bbar[((size_t)i * GP + p) * 2 + 1] = fre * bi + fim * br; }
    }
    bf16_t* Kb = (bf16_t*)(ws + WS_K); bf16_t* Vb = (bf16_t*)(ws + WS_V);
    for (int i = tid; i < (KROWS - LTOT) * QKW; i += nthr) { Kb[(size_t)LTOT * QKW + i] = 0; Vb[(size_t)LTOT * QKW + i] = 0; }
}

struct NG_ {
    const void* A; const int* rows; const float* kgain; const float* B; const float* B2; const int* goff; const int* gcnt; size_t bstride;
    int lda, ldb, M, N, K, pad;
};
static NG_ mk(const void* A, int lda, const int* rows, const float* kgain, const float* B, int ldb, const float* B2, size_t bstride, int M, int N, int K, const int* goff, const int* gcnt) {
    NG_ g{}; g.A = A; g.rows = rows; g.kgain = kgain; g.B = B; g.B2 = B2; g.goff = goff; g.gcnt = gcnt; g.bstride = bstride; g.lda = lda; g.ldb = ldb; g.M = M; g.N = N; g.K = K; g.pad = 0; return g;
}
template <class Epi, bool A_BF16, bool DUAL>
__global__ void __launch_bounds__(256) k_ngemm(NG_ g, Epi E) {
    __shared__ float As[16][68];
    __shared__ float Bs[16][68];
    __shared__ float Bs2[DUAL ? 16 : 1][68];
    __shared__ float Ct[64][65];
    __shared__ float Ct2[DUAL ? 64 : 1][65];
    const int tid = threadIdx.x, e = blockIdx.z;
    int M = g.M, rowbase = 0;
    if (g.goff) { M = g.gcnt[e]; rowbase = g.goff[e]; }
    const int m0 = blockIdx.y * 64, n0 = blockIdx.x * 64;
    if (m0 >= M) return;
    const float* B = g.B + (size_t)e * g.bstride; const float* B2 = DUAL ? g.B2 + (size_t)e * g.bstride : nullptr;
    const int ar = tid >> 2, akq = (tid & 3) * 4;
    const int bk = tid >> 4, bn = (tid & 15) * 4;
    const int ty = tid >> 4, tx = tid & 15;
    const bool arow_ok = (m0 + ar) < M;
    long asrc = 0;
    if (arow_ok) { const int r = rowbase + m0 + ar; asrc = g.rows ? (long)g.rows[r] : (long)r; }
    float acc[4][4] = {}, acc2[4][4] = {};
    for (int k0 = 0; k0 < g.K; k0 += 16) {
        float a4[4] = {0.f, 0.f, 0.f, 0.f};
        if (arow_ok) {
            if (A_BF16) { const ushort4 v = *(const ushort4*)((const bf16_t*)g.A + asrc * g.lda + k0 + akq); a4[0] = bf2f(v.x); a4[1] = bf2f(v.y); a4[2] = bf2f(v.z); a4[3] = bf2f(v.w); }
            else { const float4 v = *(const float4*)((const float*)g.A + asrc * g.lda + k0 + akq); a4[0] = v.x; a4[1] = v.y; a4[2] = v.z; a4[3] = v.w; }
            if (g.kgain) { const float4 kg = *(const float4*)(g.kgain + k0 + akq); a4[0] *= kg.x; a4[1] *= kg.y; a4[2] *= kg.z; a4[3] *= kg.w; }
        }
#pragma unroll
        for (int i = 0; i < 4; ++i) As[akq + i][ar] = a4[i];
        { const float4 v = *(const float4*)(B + (size_t)(k0 + bk) * g.ldb + n0 + bn); Bs[bk][bn] = v.x; Bs[bk][bn + 1] = v.y; Bs[bk][bn + 2] = v.z; Bs[bk][bn + 3] = v.w; }
        if (DUAL) { const float4 v = *(const float4*)(B2 + (size_t)(k0 + bk) * g.ldb + n0 + bn); Bs2[bk][bn] = v.x; Bs2[bk][bn + 1] = v.y; Bs2[bk][bn + 2] = v.z; Bs2[bk][bn + 3] = v.w; }
        __syncthreads();
#pragma unroll
        for (int k = 0; k < 16; ++k) {
            float a[4], b[4], b2[4];
#pragma unroll
            for (int i = 0; i < 4; ++i) { a[i] = As[k][ty * 4 + i]; b[i] = Bs[k][tx * 4 + i]; if (DUAL) b2[i] = Bs2[k][tx * 4 + i]; }
#pragma unroll
            for (int i = 0; i < 4; ++i)
#pragma unroll
                for (int j = 0; j < 4; ++j) { acc[i][j] += a[i] * b[j]; if (DUAL) acc2[i][j] += a[i] * b2[j]; }
        }
        __syncthreads();
    }
#pragma unroll
    for (int i = 0; i < 4; ++i)
#pragma unroll
        for (int j = 0; j < 4; ++j) { Ct[ty * 4 + i][tx * 4 + j] = acc[i][j]; if (DUAL) Ct2[ty * 4 + i][tx * 4 + j] = acc2[i][j]; }
    __syncthreads();
    const int rr = tid >> 2, cq = (tid & 3) * 16;
    E.tile(&Ct[rr][cq], DUAL ? &Ct2[rr][cq] : nullptr, rowbase + m0 + rr, (m0 + rr) < M, n0 + cq, n0, e);
}

struct EpiInProj {
    unsigned char* ws; const float* qn; const float* kn;
    DEV void tile(const float* c, const float*, int row, bool ok, int col, int n0, int) const {
        const float rs = ((const float*)(ws + WS_CTL + C_RSTDX))[ok ? row : 0];
        float v[16]; float ss = 0.f;
#pragma unroll
        for (int i = 0; i < 16; ++i) { v[i] = c[i] * rs; ss += v[i] * v[i]; }
        ss += __shfl_xor(ss, 1); ss += __shfl_xor(ss, 2);
        if (!ok) return;
        if (n0 < 2 * QKW) {
            const float r = rsqrtf(ss * (1.0f / 64.0f) + EPS);
            const bool isq = n0 < QKW; const int cc = isq ? col : col - QKW; const int d0 = cc & 63;
            if (isq) { if (row < T) { bf16_t* o = (bf16_t*)(ws + WS_Q) + (size_t)row * QKW + cc;
#pragma unroll
                for (int i = 0; i < 16; ++i) o[i] = f2bf(v[i] * r * qn[d0 + i] * C2); } }
            else { bf16_t* o = (bf16_t*)(ws + WS_K) + (size_t)row * QKW + cc;
#pragma unroll
                for (int i = 0; i < 16; ++i) o[i] = f2bf(v[i] * r * kn[d0 + i]); }
        } else if (n0 < 3 * QKW) {
            bf16_t* o = (bf16_t*)(ws + WS_V) + (size_t)row * QKW + (col - 2 * QKW);
#pragma unroll
            for (int i = 0; i < 16; ++i) o[i] = f2bf(v[i]);
        } else {
            const int cu = col - 3 * QKW, gidx = cu >> 4;
            if (row < T) { bf16_t* o = (bf16_t*)(ws + WS_UX) + ((size_t)gidx * NCH + (row >> 5)) * 768 + (row & 31) * 16;
#pragma unroll
                for (int i = 0; i < 16; ++i) o[i] = f2bf(v[i]); }
            else { float* o = (float*)(ws + WS_CTL + C_UMETA) + (size_t)(row - T) * SSMW + cu;
#pragma unroll
                for (int i = 0; i < 16; ++i) o[i] = v[i]; }
        }
    }
};
struct EpiGlu {
    unsigned char* ws; const float* bglu;
    DEV void tile(const float* c, const float*, int row, bool ok, int col, int, int) const {
        if (!ok) return;
        const bf16_t* ys = (const bf16_t*)(ws + WS_YS) + (size_t)row * SSMW + col; bf16_t* o = (bf16_t*)(ws + WS_CAT) + (size_t)row * DM + col;
#pragma unroll
        for (int i = 0; i < 16; ++i) o[i] = f2bf(bf2f(ys[i]) * sigmoidf_(c[i] + bglu[col + i]));
    }
};
struct EpiOut1 {
    unsigned char* ws;
    DEV void tile(const float* c, const float*, int row, bool ok, int col, int, int) const {
        if (!ok) return; const float rs = ((const float*)(ws + WS_CTL + C_RSTDS))[row]; float* o = (float*)(ws + WS_TMP) + (size_t)row * DM + col;
#pragma unroll
        for (int i = 0; i < 16; ++i) o[i] = c[i] * rs;
    }
};
struct EpiOut2 {
    unsigned char* ws; const float* x;
    DEV void tile(const float* c, const float*, int row, bool ok, int col, int, int) const {
        if (!ok) return; const float* t = (const float*)(ws + WS_TMP) + (size_t)row * DM + col; const float* xr = x + (size_t)row * DM + col;
        float* h = (float*)(ws + WS_H) + (size_t)row * DM + col; bf16_t* hb = (bf16_t*)(ws + WS_HB) + (size_t)row * DM + col;
#pragma unroll
        for (int i = 0; i < 16; ++i) { const float v = xr[i] + t[i] + c[i]; h[i] = v; hb[i] = f2bf(v); }
    }
};
struct EpiRouter {
    unsigned char* ws;
    DEV void tile(const float* c, const float*, int row, bool ok, int col, int, int) const {
        if (!ok) return; const float rs = ((const float*)(ws + WS_CTL + C_RSTDH))[row]; float* o = (float*)(ws + WS_LOGIT) + (size_t)row * NE + col;
#pragma unroll
        for (int i = 0; i < 16; ++i) o[i] = c[i] * rs;
    }
};
struct EpiGateUp {
    unsigned char* ws; int shared; int pad;
    DEV void tile(const float* c, const float* c2, int row, bool ok, int col, int, int) const {
        if (!ok) return;
        const int tok = shared ? row : ((const int*)(ws + WS_CTL + C_STOK))[row];
        const float rs = ((const float*)(ws + WS_CTL + C_RSTDH))[tok];
        bf16_t* o = (shared ? (bf16_t*)(ws + WS_HS) : (bf16_t*)(ws + WS_H1)) + (size_t)row * EH + col;
#pragma unroll
        for (int i = 0; i < 16; ++i) { const float gg = c[i] * rs, uu = c2[i] * rs; o[i] = f2bf(gg * sigmoidf_(gg) * uu); }
    }
};
struct EpiDown {
    unsigned char* ws;
    DEV void tile(const float* c, const float*, int row, bool ok, int col, int, int) const {
        if (!ok) return; const int dst = ((const int*)(ws + WS_CTL + C_SDST))[row]; if (dst < 0) return;
        const float w = ((const float*)(ws + WS_CTL + C_SW))[row]; bf16_t* o = (bf16_t*)(ws + WS_Y) + (size_t)dst * DM + col;
#pragma unroll
        for (int i = 0; i < 16; ++i) o[i] = f2bf(c[i] * w);
    }
};
struct EpiFinal {
    unsigned char* ws; float* out;
    DEV void tile(const float* c, const float*, int row, bool ok, int col, int, int) const {
        if (!ok) return; const float* h = (const float*)(ws + WS_H) + (size_t)row * DM + col; const bf16_t* y = (const bf16_t*)(ws + WS_Y) + (size_t)row * TOPK * DM + col;
#pragma unroll
        for (int i = 0; i < 16; ++i) { float v = h[i] + c[i];
#pragma unroll
            for (int k = 0; k < TOPK; ++k) v += bf2f(y[(size_t)k * DM + i]);
            out[(size_t)row * DM + col + i] = v; }
    }
};

__global__ void __launch_bounds__(256) k_attn_oracle(unsigned char* ws) {
    __shared__ float Ks[32][128];
    __shared__ float Vs[32][128];
    __shared__ float lut[LUTN];
    const int tid = threadIdx.x, h = blockIdx.y, c = tid >> 7, r = blockIdx.x * 128 + (tid & 127);
    const bf16_t* Q = (const bf16_t*)(ws + WS_Q); const bf16_t* Kb = (const bf16_t*)(ws + WS_K); const bf16_t* Vb = (const bf16_t*)(ws + WS_V);
    for (int i = tid; i < LUTN; i += 256) lut[i] = ((const float*)(ws + WS_CTL + C_LUT))[h * LUTN + i];
    float q[64];
#pragma unroll
    for (int d = 0; d < 64; ++d) q[d] = bf2f(Q[(size_t)r * QKW + h * 128 + c * 64 + d]);
    float o[128];
#pragma unroll
    for (int i = 0; i < 128; ++i) o[i] = 0.f;
    float l = 0.f;
    const int posq = 16 + r;
    for (int k0 = 0; k0 < KROWS; k0 += 32) {
        __syncthreads();
        { const int key = tid >> 3, seg = (tid & 7) * 16; const bf16_t* kp = Kb + (size_t)(k0 + key) * QKW + h * 128 + seg; const bf16_t* vp = Vb + (size_t)(k0 + key) * QKW + h * 128 + seg;
#pragma unroll
            for (int i = 0; i < 16; ++i) { Ks[key][seg + i] = bf2f(kp[i]); Vs[key][seg + i] = bf2f(vp[i]); } }
        __syncthreads();
        for (int j = 0; j < 32; ++j) {
            const int key = k0 + j; if (key >= LTOT) break;
            float s = 0.f;
#pragma unroll
            for (int d = 0; d < 64; ++d) s += q[d] * Ks[j][c * 64 + d];
            const int posk = key < T ? 16 + key : key - T; int rel = posk - posq; rel = rel < -91 ? -91 : (rel > 91 ? 91 : rel);
            const float p = exp2f(s + lut[rel + 91]);
            l += p;
#pragma unroll
            for (int i = 0; i < 128; ++i) o[i] += p * Vs[j][i];
        }
    }
    float* O = (float*)(ws + WS_OACC) + ((size_t)(r * NH + h) * 2 + c) * DV; const float il = 1.0f / l;
#pragma unroll
    for (int i = 0; i < 128; ++i) O[i] = o[i] * il;
}
__global__ void __launch_bounds__(256) k_attn_combine(In in, unsigned char* ws) {
    const int w = (blockIdx.x * 256 + threadIdx.x) >> 6, lane = threadIdx.x & 63; if (w >= T * NH) return;
    const int r = w >> 3, h = w & 7; const float lam = *(const float*)(ws + WS_CTL + C_LAM);
    const float* O = (const float*)(ws + WS_OACC) + (size_t)(r * NH + h) * 2 * DV;
    const float v0 = O[lane] - lam * O[DV + lane], v1 = O[64 + lane] - lam * O[DV + 64 + lane];
    const float ms = wave_sum(v0 * v0 + v1 * v1) * (1.0f / DV); const float rs = rsqrtf(ms + EPS) * 0.8f;
    bf16_t* o = (bf16_t*)(ws + WS_CAT) + (size_t)r * DM + SSMW + h * DV;
    o[lane] = f2bf(v0 * rs * in.subln[lane]); o[64 + lane] = f2bf(v1 * rs * in.subln[64 + lane]);
}

__global__ void __launch_bounds__(64) k_ssm_oracle(In in, unsigned char* ws) {
    __shared__ float us[TC * GP];
    __shared__ float st[2 * NST];
    const int dg = blockIdx.x, dir = dg >> 6, g = dg & 63, lane = threadIdx.x;
    const float* abar = (const float*)(ws + WS_CTL + C_SSMP); const float* bbar = abar + 2 * 64 * 64 * 2;
    const int n = lane; const int pi = dg * NST + n;
    const float ar = abar[pi * 2], ai = abar[pi * 2 + 1];
    float br[GP], bi[GP];
#pragma unroll
    for (int p = 0; p < GP; ++p) { br[p] = bbar[((size_t)pi * GP + p) * 2]; bi[p] = bbar[((size_t)pi * GP + p) * 2 + 1]; }
    const int op = lane & 15, oq = lane >> 4;
    float cr[16], ci[16];
#pragma unroll
    for (int i = 0; i < 16; ++i) { const size_t ix = ((size_t)dg * GP + op) * NST + oq * 16 + i; cr[i] = in.c_re[ix]; ci[i] = in.c_im[ix]; }
    float sr = 0.f, si = 0.f;
    const bf16_t* UX = (const bf16_t*)(ws + WS_UX) + (size_t)g * NCH * 768;
    float* Yo = (float*)(ws + (dir ? WS_YR : WS_YF));
    if (dir == 0) {
        const float* um = (const float*)(ws + WS_CTL + C_UMETA);
        for (int j = 0; j < NMETA; ++j) { float bur = 0.f, bui = 0.f;
#pragma unroll
            for (int p = 0; p < GP; ++p) { const float u = um[(size_t)j * SSMW + g * GP + p]; bur += br[p] * u; bui += bi[p] * u; }
            const float nr = ar * sr - ai * si + bur, ni = ar * si + ai * sr + bui; sr = nr; si = ni; }
    }
    for (int cc = 0; cc < NCH; ++cc) {
        const int c = dir ? NCH - 1 - cc : cc;
        __syncthreads();
        { const bf16_t* src = UX + (size_t)c * 768 + lane * 8;
#pragma unroll
            for (int i = 0; i < 8; ++i) us[lane * 8 + i] = bf2f(src[i]); }
        __syncthreads();
        for (int jj = 0; jj < TC; ++jj) {
            const int j = dir ? TC - 1 - jj : jj;
            float bur = 0.f, bui = 0.f;
#pragma unroll
            for (int p = 0; p < GP; ++p) { const float u = us[j * GP + p]; bur += br[p] * u; bui += bi[p] * u; }
            const float nr = ar * sr - ai * si + bur, ni = ar * si + ai * sr + bui; sr = nr; si = ni;
            __syncthreads();
            st[n] = sr; st[NST + n] = si;
            __syncthreads();
            float y = 0.f;
#pragma unroll
            for (int i = 0; i < 16; ++i) y += cr[i] * st[oq * 16 + i] - ci[i] * st[NST + oq * 16 + i];
            y += __shfl_xor(y, 16); y += __shfl_xor(y, 32);
            if (lane < 16) Yo[(size_t)(c * TC + j) * SSMW + g * GP + op] = y;
        }
    }
}
__global__ void __launch_bounds__(256) k_ssm_post(In in, unsigned char* ws) {
    const size_t i = (size_t)blockIdx.x * 256 + threadIdx.x; if (i >= (size_t)T * SSMW) return;
    const int r = (int)(i >> 10), cidx = (int)(i & 1023), g = cidx >> 4, p = cidx & 15;
    const float u = bf2f(((const bf16_t*)(ws + WS_UX))[((size_t)g * NCH + (r >> 5)) * 768 + (r & 31) * 16 + p]);
    const float y = in.ssm_d[cidx] * u + ((const float*)(ws + WS_YF))[i] + ((const float*)(ws + WS_YR))[i];
    ((bf16_t*)(ws + WS_YS))[i] = f2bf(gelu_tanh(y));
}
__global__ void __launch_bounds__(256) k_rstd_ssm(unsigned char* ws) {
    const int w = (blockIdx.x * 256 + threadIdx.x) >> 6, lane = threadIdx.x & 63; if (w >= T) return;
    const bf16_t* c = (const bf16_t*)(ws + WS_CAT) + (size_t)w * DM; float ss = 0.f;
    for (int j = 0; j < SSMW / 64; ++j) { const float v = bf2f(c[j * 64 + lane]); ss += v * v; }
    ss = wave_sum(ss); if (lane == 0) ((float*)(ws + WS_CTL + C_RSTDS))[w] = rsqrtf(ss * (1.0f / SSMW) + EPS);
}
__global__ void __launch_bounds__(256) k_rstd_h(unsigned char* ws) {
    const int w = (blockIdx.x * 256 + threadIdx.x) >> 6, lane = threadIdx.x & 63; if (w >= T) return;
    const float* h = (const float*)(ws + WS_H) + (size_t)w * DM; float ss = 0.f;
    for (int j = 0; j < DM / 64; ++j) { const float v = h[j * 64 + lane]; ss += v * v; }
    ss = wave_sum(ss); if (lane == 0) ((float*)(ws + WS_CTL + C_RSTDH))[w] = rsqrtf(ss * (1.0f / DM) + EPS);
}

__global__ void __launch_bounds__(256) k_route(In in, unsigned char* ws) {
    const int t = (blockIdx.x * 256 + threadIdx.x) >> 6, lane = threadIdx.x & 63; if (t >= T) return;
    const float score = sigmoidf_(((const float*)(ws + WS_LOGIT))[(size_t)t * NE + lane]);
    const float choice = score + in.router_bias[lane];
    float m1 = choice;
#pragma unroll
    for (int o = 1; o < 8; o <<= 1) m1 = fmaxf(m1, __shfl_xor(m1, o));
    const unsigned long long b1 = __ballot(choice == m1); const int gbase = lane & ~7;
    const unsigned gb = (unsigned)((b1 >> gbase) & 0xffull); const int first = gbase + __builtin_ctz(gb);
    float m2 = (lane == first) ? -INFINITY : choice;
#pragma unroll
    for (int o = 1; o < 8; o <<= 1) m2 = fmaxf(m2, __shfl_xor(m2, o));
    const float gs = m1 + m2;
    int grank = 0; const int myg = lane >> 3;
#pragma unroll
    for (int j = 0; j < 8; ++j) { const float o = __shfl(gs, j * 8); grank += (o > gs || (o == gs && j < myg)) ? 1 : 0; }
    const float mv = grank < 4 ? choice : -INFINITY;
    int rank = 0;
    for (int j = 0; j < 64; ++j) { const float o = __shfl(mv, j); rank += (o > mv || (o == mv && j < lane)) ? 1 : 0; }
    const bool sel = rank < TOPK;
    const float ssum = wave_sum(sel ? score : 0.f);
    if (sel) {
        const int pos = atomicAdd((int*)(ws + WS_CTL + C_CNT) + lane, 1);
        ((int*)(ws + WS_CTL + C_IDX))[t * TOPK + rank] = lane;
        ((float*)(ws + WS_CTL + C_WTS))[t * TOPK + rank] = score / ssum * 2.5f;
        ((int*)(ws + WS_CTL + C_POS))[t * TOPK + rank] = pos;
    }
}
__global__ void __launch_bounds__(256) k_offsets(unsigned char* ws) {
    const int tid = blockIdx.x * 256 + threadIdx.x, nthr = gridDim.x * 256;
    if (tid == 0) { const int* cnt = (const int*)(ws + WS_CTL + C_CNT); int* off = (int*)(ws + WS_CTL + C_OFF); int a = 0;
        for (int e = 0; e < NE; ++e) { off[e] = a; a += (cnt[e] + 255) & ~255; } off[NE] = a; }
    int* stok = (int*)(ws + WS_CTL + C_STOK); int* sdst = (int*)(ws + WS_CTL + C_SDST); float* sw = (float*)(ws + WS_CTL + C_SW);
    for (int i = tid; i < NSLOT; i += nthr) { stok[i] = 0; sdst[i] = -1; sw[i] = 0.f; }
}
__global__ void __launch_bounds__(256) k_scatter(unsigned char* ws) {
    const int i = blockIdx.x * 256 + threadIdx.x; if (i >= T * TOPK) return;
    const int e = ((const int*)(ws + WS_CTL + C_IDX))[i]; const int slot = ((const int*)(ws + WS_CTL + C_OFF))[e] + ((const int*)(ws + WS_CTL + C_POS))[i];
    ((int*)(ws + WS_CTL + C_STOK))[slot] = i >> 3; ((int*)(ws + WS_CTL + C_SDST))[slot] = i; ((float*)(ws + WS_CTL + C_SW))[slot] = ((const float*)(ws + WS_CTL + C_WTS))[i];
}

extern "C" void kernel_launch(void* const* d_in, const int* in_sizes, int n_in, void* d_out, int out_size, void* d_ws, size_t ws_size, hipStream_t stream) {
    if (n_in != 33 || ws_size < WS_END) return;
    In in; { const float** p = (const float**)&in; for (int i = 0; i < 33; ++i) p[i] = (const float*)d_in[i]; }
    unsigned char* ws = (unsigned char*)d_ws; float* out = (float*)d_out;
    const int* cnt = (const int*)(ws + WS_CTL + C_CNT); const int* off = (const int*)(ws + WS_CTL + C_OFF);
    k_prep_x<<<(LTOT * 64 + 255) / 256, 256, 0, stream>>>(in, ws);
    k_tables<<<256, 256, 0, stream>>>(in, ws);
    { NG_ g = mk(ws + WS_XB, DM, nullptr, in.norm_mix, in.w_in, INW, nullptr, 0, LTOT, INW, DM, nullptr, nullptr);
      k_ngemm<EpiInProj, true, false><<<dim3(INW / 64, (LTOT + 63) / 64, 1), 256, 0, stream>>>(g, EpiInProj{ws, in.q_norm, in.k_norm}); }
    k_attn_oracle<<<dim3(T / 128, NH), 256, 0, stream>>>(ws);
    k_attn_combine<<<T * NH * 64 / 256, 256, 0, stream>>>(in, ws);
    k_ssm_oracle<<<2 * NG, 64, 0, stream>>>(in, ws);
    k_ssm_post<<<T * SSMW / 256, 256, 0, stream>>>(in, ws);
    { NG_ g = mk(ws + WS_YS, SSMW, nullptr, nullptr, in.w_glu, SSMW, nullptr, 0, T, SSMW, SSMW, nullptr, nullptr);
      k_ngemm<EpiGlu, true, false><<<dim3(SSMW / 64, T / 64, 1), 256, 0, stream>>>(g, EpiGlu{ws, in.b_glu}); }
    k_rstd_ssm<<<T * 64 / 256, 256, 0, stream>>>(ws);
    { NG_ g = mk(ws + WS_CAT, DM, nullptr, in.ssm_norm, in.w_out + (size_t)SSMW * DM, DM, nullptr, 0, T, DM, SSMW, nullptr, nullptr);
      k_ngemm<EpiOut1, true, false><<<dim3(DM / 64, T / 64, 1), 256, 0, stream>>>(g, EpiOut1{ws}); }
    { NG_ g = mk(ws + WS_CAT + SSMW * 2, DM, nullptr, nullptr, in.w_out, DM, nullptr, 0, T, DM, SSMW, nullptr, nullptr);
      k_ngemm<EpiOut2, true, false><<<dim3(DM / 64, T / 64, 1), 256, 0, stream>>>(g, EpiOut2{ws, in.x}); }
    k_rstd_h<<<T * 64 / 256, 256, 0, stream>>>(ws);
    { NG_ g = mk(ws + WS_H, DM, nullptr, in.norm_ffn, in.router_w, NE, nullptr, 0, T, NE, DM, nullptr, nullptr);
      k_ngemm<EpiRouter, false, false><<<dim3(1, T / 64, 1), 256, 0, stream>>>(g, EpiRouter{ws}); }
    k_route<<<T * 64 / 256, 256, 0, stream>>>(in, ws);
    k_offsets<<<64, 256, 0, stream>>>(ws);
    k_scatter<<<T * TOPK / 256, 256, 0, stream>>>(ws);
    { NG_ g = mk(ws + WS_HB, DM, (const int*)(ws + WS_CTL + C_STOK), in.norm_ffn, in.w_gate, EH, in.w_up, (size_t)DM * EH, 0, EH, DM, off, cnt);
      k_ngemm<EpiGateUp, true, true><<<dim3(EH / 64, T / 64, NE), 256, 0, stream>>>(g, EpiGateUp{ws, 0, 0}); }
    { NG_ g = mk(ws + WS_HB, DM, nullptr, in.norm_ffn, in.sh_gate, SH, in.sh_up, 0, T, SH, DM, nullptr, nullptr);
      k_ngemm<EpiGateUp, true, true><<<dim3(SH / 64, T / 64, 1), 256, 0, stream>>>(g, EpiGateUp{ws, 1, 0}); }
    { NG_ g = mk(ws + WS_H1, EH, nullptr, nullptr, in.w_down, DM, nullptr, (size_t)EH * DM, 0, DM, EH, off, cnt);
      k_ngemm<EpiDown, true, false><<<dim3(DM / 64, T / 64, NE), 256, 0, stream>>>(g, EpiDown{ws}); }
    { NG_ g = mk(ws + WS_HS, SH, nullptr, nullptr, in.sh_down, DM, nullptr, 0, T, DM, SH, nullptr, nullptr);
      k_ngemm<EpiFinal, true, false><<<dim3(DM / 64, T / 64, 1), 256, 0, stream>>>(g, EpiFinal{ws, out}); }
}
```

```cpp
#include <hip/hip_runtime.h>
#include <stdint.h>
#include <math.h>

typedef unsigned short bf16_t;
#define DEV __device__ __forceinline__

constexpr int T = 16384, NMETA = 16, LTOT = T + NMETA, DM = 2048;
constexpr int NH = 8, HD = 64, DV = 128, QKW = 1024, INW = 4096;
constexpr int NG = 64, GP = 16, NST = 64, SSMW = 1024;
constexpr int TC = 32, NCH = T / TC;
constexpr int NE = 64, TOPK = 8, EH = 512, SH = 512;
constexpr int KROWS = 16448;
constexpr int NSLOT = T * TOPK + NE * 256;
constexpr float EPS = 1e-6f;
constexpr float LOG2E = 1.4426950408889634f;
constexpr float C2 = 0.125f * LOG2E;
constexpr int LUTN = 183;

constexpr size_t MiB = 1u << 20;
constexpr size_t WS_CTL   = 0;
constexpr size_t WS_WSM   = 8 * MiB;
constexpr size_t WS_WDN   = 40 * MiB;
constexpr size_t WS_H     = 168 * MiB;
constexpr size_t WS_HS    = 296 * MiB;
constexpr size_t WS_H1    = 312 * MiB;
constexpr size_t WS_Y     = 456 * MiB;
constexpr size_t WS_WGU   = 456 * MiB;
constexpr size_t WS_HB    = 712 * MiB;
constexpr size_t WS_CAT   = 776 * MiB;
constexpr size_t WS_TAB   = 840 * MiB;
constexpr size_t WS_XB    = 904 * MiB;
constexpr size_t WS_UX    = 969 * MiB;
constexpr size_t WS_Q     = WS_H1;
constexpr size_t WS_K     = WS_H1 + 32 * MiB;
constexpr size_t WS_V     = WS_H1 + 65 * MiB;
constexpr size_t WS_OACC  = WS_H;
constexpr size_t WS_YF    = WS_H1;
constexpr size_t WS_YR    = WS_H1 + 64 * MiB;
constexpr size_t WS_YS    = WS_H + 32 * MiB;
constexpr size_t WS_TMP   = WS_H1;
constexpr size_t WS_END   = 1017 * MiB;

constexpr size_t C_BAR     = 0;
constexpr size_t C_CNT     = 13824;
constexpr size_t C_ZERO_BYTES = 16384;
constexpr size_t C_OFF     = 16384;
constexpr size_t C_LAM     = 17408;
constexpr size_t C_LUT     = 20480;
constexpr size_t C_RSTDX   = 32768;
constexpr size_t C_RSTDS   = C_RSTDX + 16640 * 4;
constexpr size_t C_RSTDH   = C_RSTDS + 16384 * 4;
constexpr size_t C_UMETA   = C_RSTDH + 16384 * 4;
constexpr size_t C_SSMP    = 512 * 1024;
constexpr size_t WS_LOGIT  = WS_XB;
constexpr size_t C_IDX     = 2 * MiB;
constexpr size_t C_WTS     = C_IDX + 512 * 1024;
constexpr size_t C_POS     = C_WTS + 512 * 1024;
constexpr size_t C_STOK    = C_POS + 512 * 1024;
constexpr size_t C_SDST    = C_STOK + 640 * 1024;
constexpr size_t C_SW      = C_SDST + 640 * 1024;
static_assert(C_SW + NSLOT * 4 <= 8 * MiB, "ctl map");
static_assert(C_SSMP + (2 * 64 * 64 * 2 + 2 * 64 * 64 * 16 * 2) * 4 <= C_IDX, "ctl map");
static_assert(C_UMETA + 16 * 1024 * 4 <= C_SSMP, "ctl map");
constexpr size_t WS_SSQ   = 6 * MiB;
constexpr size_t WS_WR    = 7 * MiB;
static_assert(C_SW + NSLOT * 4 + T * 4 <= WS_SSQ, "ctl map");
constexpr size_t WS_WT_IN   = WS_WSM;
constexpr size_t WS_WT_OUT  = WS_WSM + 16 * MiB;
constexpr size_t WS_WT_SHGU = WS_WSM + 24 * MiB;
constexpr size_t WS_WT_SHD  = WS_WSM + 28 * MiB;
constexpr size_t WS_WT_GLU  = WS_WSM + 30 * MiB;

DEV float bf2f(bf16_t b) { return __uint_as_float(((unsigned)b) << 16); }
DEV bf16_t f2bf(float f) { unsigned u = __float_as_uint(f); return (bf16_t)((u + 0x7fffu + ((u >> 16) & 1u)) >> 16); }
DEV float wave_sum(float v) {
#pragma unroll
    for (int o = 1; o < 64; o <<= 1) v += __shfl_xor(v, o);
    return v;
}
DEV float sigmoidf_(float x) { return 1.0f / (1.0f + __expf(-x)); }
DEV float gelu_tanh(float x) { const float u = 0.7978845608028654f * (x + 0.044715f * x * x * x); return 0.5f * x * (1.0f + tanhf(u)); }

struct In {
    const float *x, *meta, *rel_bias, *norm_mix, *w_in, *q_norm, *k_norm, *lam_q1, *lam_k1, *lam_q2, *lam_k2, *subln;
    const float *a_re, *a_im, *log_step, *b_re, *b_im, *c_re, *c_im, *ssm_d, *w_glu, *b_glu, *ssm_norm, *w_out, *norm_ffn;
    const float *router_w, *router_bias, *w_gate, *w_up, *w_down, *sh_gate, *sh_up, *sh_down;
};

__global__ void __launch_bounds__(256) k_prep_x(In in, unsigned char* ws) {
    const int wave = (blockIdx.x * 256 + threadIdx.x) >> 6, lane = threadIdx.x & 63;
    if (wave >= LTOT) return;
    const float* src = wave < T ? in.x + (size_t)wave * DM : in.meta + (size_t)(wave - T) * DM;
    bf16_t* dst = (bf16_t*)(ws + WS_XB) + (size_t)wave * DM;
    float ss = 0.f;
    for (int j = 0; j < DM / 256; ++j) {
        const float4 v = *(const float4*)(src + j * 256 + lane * 4);
        ss += v.x * v.x + v.y * v.y + v.z * v.z + v.w * v.w;
        ushort4 o; o.x = f2bf(v.x); o.y = f2bf(v.y); o.z = f2bf(v.z); o.w = f2bf(v.w);
        *(ushort4*)(dst + j * 256 + lane * 4) = o;
    }
    ss = wave_sum(ss);
    if (lane == 0) ((float*)(ws + WS_CTL + C_RSTDX))[wave] = rsqrtf(ss * (1.0f / DM) + EPS);
}

DEV int t5_bucket(int rel) {
    const int n = rel < 0 ? -rel : rel;
    int b;
    if (n < 8) b = n;
    else { const float nf = (float)n; int large = 8 + (int)(logf(nf / 8.0f) / 2.772588722239781f * 8.0f); b = large < 15 ? large : 15; }
    return (rel > 0 ? 16 : 0) + b;
}
__global__ void __launch_bounds__(256) k_tables(In in, unsigned char* ws) {
    const int tid = blockIdx.x * 256 + threadIdx.x, nthr = gridDim.x * 256;
    float* lut = (float*)(ws + WS_CTL + C_LUT);
    for (int i = tid; i < NH * LUTN; i += nthr) { const int h = i / LUTN, rel = i % LUTN - 91; lut[i] = in.rel_bias[t5_bucket(rel) * NH + h] * LOG2E; }
    if (tid == 0) {
        float s1 = 0.f, s2 = 0.f;
        for (int i = 0; i < HD; ++i) { s1 += in.lam_q1[i] * in.lam_k1[i]; s2 += in.lam_q2[i] * in.lam_k2[i]; }
        *(float*)(ws + WS_CTL + C_LAM) = expf(s1) - expf(s2) + 0.2f;
    }
    float* abar = (float*)(ws + WS_CTL + C_SSMP);
    float* bbar = abar + 2 * 64 * 64 * 2;
    for (int i = tid; i < 2 * NG * NST; i += nthr) {
        const int dg = i / NST;
        const float are = in.a_re[i], aim = in.a_im[i], dt = expf(in.log_step[dg]);
        const float decay = expf(are * dt); float sn, cs; sincosf(aim * dt, &sn, &cs);
        const float abr = decay * cs, abi = decay * sn, den = are * are + aim * aim, zr = abr - 1.0f;
        const float fre = (zr * are + abi * aim) / den, fim = (abi * are - zr * aim) / den;
        abar[i * 2] = abr; abar[i * 2 + 1] = abi;
        for (int p = 0; p < GP; ++p) { const float br = in.b_re[(size_t)i * GP + p], bi = in.b_im[(size_t)i * GP + p];
            bbar[((size_t)i * GP + p) * 2] = fre * br - fim * bi; bbar[((size_t)i * GP + p) * 2 + 1] = fre * bi + fim * br; }
    }
    bf16_t* Kb = (bf16_t*)(ws + WS_K); bf16_t* Vb = (bf16_t*)(ws + WS_V);
    for (int i = tid; i < (KROWS - LTOT) * QKW; i += nthr) { Kb[(size_t)LTOT * QKW + i] = 0; Vb[(size_t)LTOT * QKW + i] = 0; }
}

struct NG_ {
    const void* A; const int* rows; const float* kgain; const float* B; const float* B2; const int* goff; const int* gcnt; size_t bstride;
    int lda, ldb, M, N, K, pad;
};
static NG_ mk(const void* A, int lda, const int* rows, const float* kgain, const float* B, int ldb, const float* B2, size_t bstride, int M, int N, int K, const int* goff, const int* gcnt) {
    NG_ g{}; g.A = A; g.rows = rows; g.kgain = kgain; g.B = B; g.B2 = B2; g.goff = goff; g.gcnt = gcnt; g.bstride = bstride; g.lda = lda; g.ldb = ldb; g.M = M; g.N = N; g.K = K; g.pad = 0; return g;
}
template <class Epi, bool A_BF16, bool DUAL>
__global__ void __launch_bounds__(256) k_ngemm(NG_ g, Epi E) {
    __shared__ float As[16][68];
    __shared__ float Bs[16][68];
    __shared__ float Bs2[DUAL ? 16 : 1][68];
    __shared__ float Ct[64][65];
    __shared__ float Ct2[DUAL ? 64 : 1][65];
    const int tid = threadIdx.x, e = blockIdx.z;
    int M = g.M, rowbase = 0;
    if (g.goff) { M = g.gcnt[e]; rowbase = g.goff[e]; }
    const int m0 = blockIdx.y * 64, n0 = blockIdx.x * 64;
    if (m0 >= M) return;
    const float* B = g.B + (size_t)e * g.bstride; const float* B2 = DUAL ? g.B2 + (size_t)e * g.bstride : nullptr;
    const int ar = tid >> 2, akq = (tid & 3) * 4;
    const int bk = tid >> 4, bn = (tid & 15) * 4;
    const int ty = tid >> 4, tx = tid & 15;
    const bool arow_ok = (m0 + ar) < M;
    long asrc = 0;
    if (arow_ok) { const int r = rowbase + m0 + ar; asrc = g.rows ? (long)g.rows[r] : (long)r; }
    float acc[4][4] = {}, acc2[4][4] = {};
    for (int k0 = 0; k0 < g.K; k0 += 16) {
        float a4[4] = {0.f, 0.f, 0.f, 0.f};
        if (arow_ok) {
            if (A_BF16) { const ushort4 v = *(const ushort4*)((const bf16_t*)g.A + asrc * g.lda + k0 + akq); a4[0] = bf2f(v.x); a4[1] = bf2f(v.y); a4[2] = bf2f(v.z); a4[3] = bf2f(v.w); }
            else { const float4 v = *(const float4*)((const float*)g.A + asrc * g.lda + k0 + akq); a4[0] = v.x; a4[1] = v.y; a4[2] = v.z; a4[3] = v.w; }
            if (g.kgain) { const float4 kg = *(const float4*)(g.kgain + k0 + akq); a4[0] *= kg.x; a4[1] *= kg.y; a4[2] *= kg.z; a4[3] *= kg.w; }
        }
#pragma unroll
        for (int i = 0; i < 4; ++i) As[akq + i][ar] = a4[i];
        { const float4 v = *(const float4*)(B + (size_t)(k0 + bk) * g.ldb + n0 + bn); Bs[bk][bn] = v.x; Bs[bk][bn + 1] = v.y; Bs[bk][bn + 2] = v.z; Bs[bk][bn + 3] = v.w; }
        if (DUAL) { const float4 v = *(const float4*)(B2 + (size_t)(k0 + bk) * g.ldb + n0 + bn); Bs2[bk][bn] = v.x; Bs2[bk][bn + 1] = v.y; Bs2[bk][bn + 2] = v.z; Bs2[bk][bn + 3] = v.w; }
        __syncthreads();
#pragma unroll
        for (int k = 0; k < 16; ++k) {
            float a[4], b[4], b2[4];
#pragma unroll
            for (int i = 0; i < 4; ++i) { a[i] = As[k][ty * 4 + i]; b[i] = Bs[k][tx * 4 + i]; if (DUAL) b2[i] = Bs2[k][tx * 4 + i]; }
#pragma unroll
            for (int i = 0; i < 4; ++i)
#pragma unroll
                for (int j = 0; j < 4; ++j) { acc[i][j] += a[i] * b[j]; if (DUAL) acc2[i][j] += a[i] * b2[j]; }
        }
        __syncthreads();
    }
#pragma unroll
    for (int i = 0; i < 4; ++i)
#pragma unroll
        for (int j = 0; j < 4; ++j) { Ct[ty * 4 + i][tx * 4 + j] = acc[i][j]; if (DUAL) Ct2[ty * 4 + i][tx * 4 + j] = acc2[i][j]; }
    __syncthreads();
    const int rr = tid >> 2, cq = (tid & 3) * 16;
    E.tile(&Ct[rr][cq], DUAL ? &Ct2[rr][cq] : nullptr, rowbase + m0 + rr, (m0 + rr) < M, n0 + cq, n0, e);
}

struct EpiInProj {
    unsigned char* ws; const float* qn; const float* kn;
    DEV void tile(const float* c, const float*, int row, bool ok, int col, int n0, int) const {
        const float rs = ((const float*)(ws + WS_CTL + C_RSTDX))[ok ? row : 0];
        float v[16]; float ss = 0.f;
#pragma unroll
        for (int i = 0; i < 16; ++i) { v[i] = c[i] * rs; ss += v[i] * v[i]; }
        ss += __shfl_xor(ss, 1); ss += __shfl_xor(ss, 2);
        if (!ok) return;
        if (n0 < 2 * QKW) {
            const float r = rsqrtf(ss * (1.0f / 64.0f) + EPS);
            const bool isq = n0 < QKW; const int cc = isq ? col : col - QKW; const int d0 = cc & 63;
            if (isq) { if (row < T) { bf16_t* o = (bf16_t*)(ws + WS_Q) + (size_t)row * QKW + cc;
#pragma unroll
                for (int i = 0; i < 16; ++i) o[i] = f2bf(v[i] * r * qn[d0 + i] * C2); } }
            else { bf16_t* o = (bf16_t*)(ws + WS_K) + (size_t)row * QKW + cc;
#pragma unroll
                for (int i = 0; i < 16; ++i) o[i] = f2bf(v[i] * r * kn[d0 + i]); }
        } else if (n0 < 3 * QKW) {
            bf16_t* o = (bf16_t*)(ws + WS_V) + (size_t)row * QKW + (col - 2 * QKW);
#pragma unroll
            for (int i = 0; i < 16; ++i) o[i] = f2bf(v[i]);
        } else {
            const int cu = col - 3 * QKW, gidx = cu >> 4;
            if (row < T) { bf16_t* o = (bf16_t*)(ws + WS_UX) + ((size_t)gidx * NCH + (row >> 5)) * 768 + (row & 31) * 16;
#pragma unroll
                for (int i = 0; i < 16; ++i) o[i] = f2bf(v[i]); }
            else { float* o = (float*)(ws + WS_CTL + C_UMETA) + (size_t)(row - T) * SSMW + cu;
#pragma unroll
                for (int i = 0; i < 16; ++i) o[i] = v[i]; }
        }
    }
};
struct EpiGlu {
    unsigned char* ws; const float* bglu;
    DEV void tile(const float* c, const float*, int row, bool ok, int col, int, int) const {
        if (!ok) return;
        const bf16_t* ys = (const bf16_t*)(ws + WS_YS) + (size_t)row * SSMW + col; bf16_t* o = (bf16_t*)(ws + WS_CAT) + (size_t)row * DM + col;
#pragma unroll
        for (int i = 0; i < 16; ++i) o[i] = f2bf(bf2f(ys[i]) * sigmoidf_(c[i] + bglu[col + i]));
    }
};
struct EpiOut1 {
    unsigned char* ws;
    DEV void tile(const float* c, const float*, int row, bool ok, int col, int, int) const {
        if (!ok) return; const float rs = ((const float*)(ws + WS_CTL + C_RSTDS))[row]; float* o = (float*)(ws + WS_TMP) + (size_t)row * DM + col;
#pragma unroll
        for (int i = 0; i < 16; ++i) o[i] = c[i] * rs;
    }
};
struct EpiOut2 {
    unsigned char* ws; const float* x;
    DEV void tile(const float* c, const float*, int row, bool ok, int col, int, int) const {
        if (!ok) return; const float* t = (const float*)(ws + WS_TMP) + (size_t)row * DM + col; const float* xr = x + (size_t)row * DM + col;
        float* h = (float*)(ws + WS_H) + (size_t)row * DM + col; bf16_t* hb = (bf16_t*)(ws + WS_HB) + (size_t)row * DM + col;
#pragma unroll
        for (int i = 0; i < 16; ++i) { const float v = xr[i] + t[i] + c[i]; h[i] = v; hb[i] = f2bf(v); }
    }
};
struct EpiRouter {
    unsigned char* ws;
    DEV void tile(const float* c, const float*, int row, bool ok, int col, int, int) const {
        if (!ok) return; const float rs = ((const float*)(ws + WS_CTL + C_RSTDH))[row]; float* o = (float*)(ws + WS_LOGIT) + (size_t)row * NE + col;
#pragma unroll
        for (int i = 0; i < 16; ++i) o[i] = c[i] * rs;
    }
};
struct EpiGateUp {
    unsigned char* ws; int shared; int pad;
    DEV void tile(const float* c, const float* c2, int row, bool ok, int col, int, int) const {
        if (!ok) return;
        const int tok = shared ? row : ((const int*)(ws + WS_CTL + C_STOK))[row];
        const float rs = ((const float*)(ws + WS_CTL + C_RSTDH))[tok];
        bf16_t* o = (shared ? (bf16_t*)(ws + WS_HS) : (bf16_t*)(ws + WS_H1)) + (size_t)row * EH + col;
#pragma unroll
        for (int i = 0; i < 16; ++i) { const float gg = c[i] * rs, uu = c2[i] * rs; o[i] = f2bf(gg * sigmoidf_(gg) * uu); }
    }
};
struct EpiDown {
    unsigned char* ws;
    DEV void tile(const float* c, const float*, int row, bool ok, int col, int, int) const {
        if (!ok) return; const int dst = ((const int*)(ws + WS_CTL + C_SDST))[row]; if (dst < 0) return;
        const float w = ((const float*)(ws + WS_CTL + C_SW))[row]; bf16_t* o = (bf16_t*)(ws + WS_Y) + (size_t)dst * DM + col;
#pragma unroll
        for (int i = 0; i < 16; ++i) o[i] = f2bf(c[i] * w);
    }
};
struct EpiFinal {
    unsigned char* ws; float* out;
    DEV void tile(const float* c, const float*, int row, bool ok, int col, int, int) const {
        if (!ok) return; const float* h = (const float*)(ws + WS_H) + (size_t)row * DM + col; const bf16_t* y = (const bf16_t*)(ws + WS_Y) + (size_t)row * TOPK * DM + col;
#pragma unroll
        for (int i = 0; i < 16; ++i) { float v = h[i] + c[i];
#pragma unroll
            for (int k = 0; k < TOPK; ++k) v += bf2f(y[(size_t)k * DM + i]);
            out[(size_t)row * DM + col + i] = v; }
    }
};

__global__ void __launch_bounds__(256) k_attn_oracle(unsigned char* ws) {
    __shared__ float Ks[32][128];
    __shared__ float Vs[32][128];
    __shared__ float lut[LUTN];
    const int tid = threadIdx.x, h = blockIdx.y, c = tid >> 7, r = blockIdx.x * 128 + (tid & 127);
    const bf16_t* Q = (const bf16_t*)(ws + WS_Q); const bf16_t* Kb = (const bf16_t*)(ws + WS_K); const bf16_t* Vb = (const bf16_t*)(ws + WS_V);
    for (int i = tid; i < LUTN; i += 256) lut[i] = ((const float*)(ws + WS_CTL + C_LUT))[h * LUTN + i];
    float q[64];
#pragma unroll
    for (int d = 0; d < 64; ++d) q[d] = bf2f(Q[(size_t)r * QKW + h * 128 + c * 64 + d]);
    float o[128];
#pragma unroll
    for (int i = 0; i < 128; ++i) o[i] = 0.f;
    float l = 0.f;
    const int posq = 16 + r;
    for (int k0 = 0; k0 < KROWS; k0 += 32) {
        __syncthreads();
        { const int key = tid >> 3, seg = (tid & 7) * 16; const bf16_t* kp = Kb + (size_t)(k0 + key) * QKW + h * 128 + seg; const bf16_t* vp = Vb + (size_t)(k0 + key) * QKW + h * 128 + seg;
#pragma unroll
            for (int i = 0; i < 16; ++i) { Ks[key][seg + i] = bf2f(kp[i]); Vs[key][seg + i] = bf2f(vp[i]); } }
        __syncthreads();
        for (int j = 0; j < 32; ++j) {
            const int key = k0 + j; if (key >= LTOT) break;
            float s = 0.f;
#pragma unroll
            for (int d = 0; d < 64; ++d) s += q[d] * Ks[j][c * 64 + d];
            const int posk = key < T ? 16 + key : key - T; int rel = posk - posq; rel = rel < -91 ? -91 : (rel > 91 ? 91 : rel);
            const float p = exp2f(s + lut[rel + 91]);
            l += p;
#pragma unroll
            for (int i = 0; i < 128; ++i) o[i] += p * Vs[j][i];
        }
    }
    float* O = (float*)(ws + WS_OACC) + ((size_t)(r * NH + h) * 2 + c) * DV; const float il = 1.0f / l;
#pragma unroll
    for (int i = 0; i < 128; ++i) O[i] = o[i] * il;
}
__global__ void __launch_bounds__(256) k_attn_combine(In in, unsigned char* ws) {
    const int w = (blockIdx.x * 256 + threadIdx.x) >> 6, lane = threadIdx.x & 63; if (w >= T * NH) return;
    const int r = w >> 3, h = w & 7; const float lam = *(const float*)(ws + WS_CTL + C_LAM);
    const float* O = (const float*)(ws + WS_OACC) + (size_t)(r * NH + h) * 2 * DV;
    const float v0 = O[lane] - lam * O[DV + lane], v1 = O[64 + lane] - lam * O[DV + 64 + lane];
    const float ms = wave_sum(v0 * v0 + v1 * v1) * (1.0f / DV); const float rs = rsqrtf(ms + EPS) * 0.8f;
    bf16_t* o = (bf16_t*)(ws + WS_CAT) + (size_t)r * DM + SSMW + h * DV;
    o[lane] = f2bf(v0 * rs * in.subln[lane]); o[64 + lane] = f2bf(v1 * rs * in.subln[64 + lane]);
}

__global__ void __launch_bounds__(64) k_ssm_oracle(In in, unsigned char* ws) {
    __shared__ float us[TC * GP];
    __shared__ float st[2 * NST];
    const int dg = blockIdx.x, dir = dg >> 6, g = dg & 63, lane = threadIdx.x;
    const float* abar = (const float*)(ws + WS_CTL + C_SSMP); const float* bbar = abar + 2 * 64 * 64 * 2;
    const int n = lane; const int pi = dg * NST + n;
    const float ar = abar[pi * 2], ai = abar[pi * 2 + 1];
    float br[GP], bi[GP];
#pragma unroll
    for (int p = 0; p < GP; ++p) { br[p] = bbar[((size_t)pi * GP + p) * 2]; bi[p] = bbar[((size_t)pi * GP + p) * 2 + 1]; }
    const int op = lane & 15, oq = lane >> 4;
    float cr[16], ci[16];
#pragma unroll
    for (int i = 0; i < 16; ++i) { const size_t ix = ((size_t)dg * GP + op) * NST + oq * 16 + i; cr[i] = in.c_re[ix]; ci[i] = in.c_im[ix]; }
    float sr = 0.f, si = 0.f;
    const bf16_t* UX = (const bf16_t*)(ws + WS_UX) + (size_t)g * NCH * 768;
    float* Yo = (float*)(ws + (dir ? WS_YR : WS_YF));
    if (dir == 0) {
        const float* um = (const float*)(ws + WS_CTL + C_UMETA);
        for (int j = 0; j < NMETA; ++j) { float bur = 0.f, bui = 0.f;
#pragma unroll
            for (int p = 0; p < GP; ++p) { const float u = um[(size_t)j * SSMW + g * GP + p]; bur += br[p] * u; bui += bi[p] * u; }
            const float nr = ar * sr - ai * si + bur, ni = ar * si + ai * sr + bui; sr = nr; si = ni; }
    }
    for (int cc = 0; cc < NCH; ++cc) {
        const int c = dir ? NCH - 1 - cc : cc;
        __syncthreads();
        { const bf16_t* src = UX + (size_t)c * 768 + lane * 8;
#pragma unroll
            for (int i = 0; i < 8; ++i) us[lane * 8 + i] = bf2f(src[i]); }
        __syncthreads();
        for (int jj = 0; jj < TC; ++jj) {
            const int j = dir ? TC - 1 - jj : jj;
            float bur = 0.f, bui = 0.f;
#pragma unroll
            for (int p = 0; p < GP; ++p) { const float u = us[j * GP + p]; bur += br[p] * u; bui += bi[p] * u; }
            const float nr = ar * sr - ai * si + bur, ni = ar * si + ai * sr + bui; sr = nr; si = ni;
            __syncthreads();
            st[n] = sr; st[NST + n] = si;
            __syncthreads();
            float y = 0.f;
#pragma unroll
            for (int i = 0; i < 16; ++i) y += cr[i] * st[oq * 16 + i] - ci[i] * st[NST + oq * 16 + i];
            y += __shfl_xor(y, 16); y += __shfl_xor(y, 32);
            if (lane < 16) Yo[(size_t)(c * TC + j) * SSMW + g * GP + op] = y;
        }
    }
}
__global__ void __launch_bounds__(256) k_ssm_post(In in, unsigned char* ws) {
    const size_t i = (size_t)blockIdx.x * 256 + threadIdx.x; if (i >= (size_t)T * SSMW) return;
    const int r = (int)(i >> 10), cidx = (int)(i & 1023), g = cidx >> 4, p = cidx & 15;
    const float u = bf2f(((const bf16_t*)(ws + WS_UX))[((size_t)g * NCH + (r >> 5)) * 768 + (r & 31) * 16 + p]);
    const float y = in.ssm_d[cidx] * u + ((const float*)(ws + WS_YF))[i] + ((const float*)(ws + WS_YR))[i];
    ((bf16_t*)(ws + WS_YS))[i] = f2bf(gelu_tanh(y));
}
__global__ void __launch_bounds__(256) k_rstd_ssm(unsigned char* ws) {
    const int w = (blockIdx.x * 256 + threadIdx.x) >> 6, lane = threadIdx.x & 63; if (w >= T) return;
    const bf16_t* c = (const bf16_t*)(ws + WS_CAT) + (size_t)w * DM; float ss = 0.f;
    for (int j = 0; j < SSMW / 64; ++j) { const float v = bf2f(c[j * 64 + lane]); ss += v * v; }
    ss = wave_sum(ss); if (lane == 0) ((float*)(ws + WS_CTL + C_RSTDS))[w] = rsqrtf(ss * (1.0f / SSMW) + EPS);
}
__global__ void __launch_bounds__(256) k_rstd_h(unsigned char* ws) {
    const int w = (blockIdx.x * 256 + threadIdx.x) >> 6, lane = threadIdx.x & 63; if (w >= T) return;
    const float* h = (const float*)(ws + WS_H) + (size_t)w * DM; float ss = 0.f;
    for (int j = 0; j < DM / 64; ++j) { const float v = h[j * 64 + lane]; ss += v * v; }
    ss = wave_sum(ss); if (lane == 0) ((float*)(ws + WS_CTL + C_RSTDH))[w] = rsqrtf(ss * (1.0f / DM) + EPS);
}

__global__ void __launch_bounds__(256) k_route(In in, unsigned char* ws) {
    const int t = (blockIdx.x * 256 + threadIdx.x) >> 6, lane = threadIdx.x & 63; if (t >= T) return;
    const float score = sigmoidf_(((const float*)(ws + WS_LOGIT))[(size_t)t * NE + lane]);
    const float choice = score + in.router_bias[lane];
    float m1 = choice;
#pragma unroll
    for (int o = 1; o < 8; o <<= 1) m1 = fmaxf(m1, __shfl_xor(m1, o));
    const unsigned long long b1 = __ballot(choice == m1); const int gbase = lane & ~7;
    const unsigned gb = (unsigned)((b1 >> gbase) & 0xffull); const int first = gbase + __builtin_ctz(gb);
    float m2 = (lane == first) ? -INFINITY : choice;
#pragma unroll
    for (int o = 1; o < 8; o <<= 1) m2 = fmaxf(m2, __shfl_xor(m2, o));
    const float gs = m1 + m2;
    int grank = 0; const int myg = lane >> 3;
#pragma unroll
    for (int j = 0; j < 8; ++j) { const float o = __shfl(gs, j * 8); grank += (o > gs || (o == gs && j < myg)) ? 1 : 0; }
    const float mv = grank < 4 ? choice : -INFINITY;
    int rank = 0;
    for (int j = 0; j < 64; ++j) { const float o = __shfl(mv, j); rank += (o > mv || (o == mv && j < lane)) ? 1 : 0; }
    const bool sel = rank < TOPK;
    const float ssum = wave_sum(sel ? score : 0.f);
    if (sel) {
        const int pos = atomicAdd((int*)(ws + WS_CTL + C_CNT) + lane, 1);
        ((int*)(ws + WS_CTL + C_IDX))[t * TOPK + rank] = lane;
        ((float*)(ws + WS_CTL + C_WTS))[t * TOPK + rank] = score / ssum * 2.5f;
        ((int*)(ws + WS_CTL + C_POS))[t * TOPK + rank] = pos;
    }
}
__global__ void __launch_bounds__(256) k_offsets(unsigned char* ws) {
    const int tid = blockIdx.x * 256 + threadIdx.x, nthr = gridDim.x * 256;
    if (tid == 0) { const int* cnt = (const int*)(ws + WS_CTL + C_CNT); int* off = (int*)(ws + WS_CTL + C_OFF); int a = 0;
        for (int e = 0; e < NE; ++e) { off[e] = a; a += (cnt[e] + 255) & ~255; } off[NE] = a; }
    int* stok = (int*)(ws + WS_CTL + C_STOK); int* sdst = (int*)(ws + WS_CTL + C_SDST); float* sw = (float*)(ws + WS_CTL + C_SW);
    for (int i = tid; i < NSLOT; i += nthr) { stok[i] = 0; sdst[i] = -1; sw[i] = 0.f; }
    for (int i = tid; i < T; i += nthr) stok[NSLOT + i] = i;
}
__global__ void __launch_bounds__(256) k_scatter(unsigned char* ws) {
    const int i = blockIdx.x * 256 + threadIdx.x; if (i >= T * TOPK) return;
    const int e = ((const int*)(ws + WS_CTL + C_IDX))[i]; const int slot = ((const int*)(ws + WS_CTL + C_OFF))[e] + ((const int*)(ws + WS_CTL + C_POS))[i];
    ((int*)(ws + WS_CTL + C_STOK))[slot] = i >> 3; ((int*)(ws + WS_CTL + C_SDST))[slot] = i; ((float*)(ws + WS_CTL + C_SW))[slot] = ((const float*)(ws + WS_CTL + C_WTS))[i];
}

namespace pg8 {
#define PG8_LAS __attribute__((address_space(3)))
typedef short bf16x8 __attribute__((ext_vector_type(8)));
typedef float f32x4 __attribute__((ext_vector_type(4)));
typedef float f32x2 __attribute__((ext_vector_type(2)));
typedef unsigned u32x4 __attribute__((ext_vector_type(4)));
constexpr int BM = 256, BK = 64, HALF = 128, HTB = HALF * BK * 2, STAGE_BYTES = 8 * HTB, NXCD = 8, WGM = 8;
__host__ __device__ __forceinline__ int lds_byte(int r, int c) { const int st = (r >> 4) * 2 + (c >> 5), rr = r & 15, cc = c & 31, ob = rr * 64 + cc * 2; return st * 1024 + (ob ^ (((ob >> 9) & 1) << 5)); }
__host__ __device__ __forceinline__ void stage_rc(int b, int& R, int& C) { const int st = b / 1024, sb = b % 1024, swz = sb ^ (((sb >> 9) & 1) << 5); R = (st >> 1) * 16 + swz / 64; C = (st & 1) * 32 + (swz % 64) / 2; }
__host__ __device__ __forceinline__ int perm32(int rho) { const int n = rho >> 4, i = rho & 15; return 8 * (i >> 2) + 4 * n + (i & 3); }
__device__ __forceinline__ unsigned cvt_pk_bf16(float lo, float hi) { unsigned r; asm volatile("v_cvt_pk_bf16_f32 %0, %1, %2" : "=v"(r) : "v"(lo), "v"(hi)); return r; }

struct Unit { const char* A; const char* B; int pm, pn, e, slot0; };

template <class Epi, class Sched, bool GATHER, bool ALIGN_EPI>
__device__ __forceinline__ void gemm_phase(PG8_LAS unsigned char* lds, const int lda, const int ldb, const int K, const Sched& S, const Epi& E, const int* __restrict__ rows) {
    const int tid = threadIdx.x, wid = __builtin_amdgcn_readfirstlane(tid >> 6), lane = tid & 63, wr = wid >> 2, wc = wid & 3, fr = lane & 15, fq = lane >> 4;
    const int nt = K / BK;
    int Rs[2], Cs[2]; unsigned voffB[2];
#pragma unroll
    for (int i = 0; i < 2; ++i) { stage_rc(tid * 16 + i * 8192, Rs[i], Cs[i]); const int Rb = (Rs[i] & ~31) + perm32(Rs[i] & 31); voffB[i] = (unsigned)(Rb * ldb + Cs[i]) * 2u; }
    const size_t kstep = (size_t)(BK * 2);
    const size_t hstepB = (size_t)HALF * ldb * 2;
    const unsigned ldsw = (unsigned)wid * 1024u;
    const int aoff = lds_byte(wr * 64 + fr, fq * 8), boff = lds_byte(wc * 32 + fr, fq * 8);
#define PG8_SA(b, h) (((b) * 2 + (h)) * HTB)
#define PG8_SB(b, h) ((4 + (b) * 2 + (h)) * HTB)
#define PG8_STAGE(bufoff, gbase, voff) do { _Pragma("unroll") for (int _i = 0; _i < 2; ++_i) \
        __builtin_amdgcn_global_load_lds((const unsigned*)((const char*)(gbase) + (voff)[_i]), (PG8_LAS unsigned*)(lds + (bufoff) + ldsw + _i * 8192), 16, 0, 0); } while (0)
#define PG8_LDA(dst, b, h) do { _Pragma("unroll") for (int m = 0; m < 4; ++m) _Pragma("unroll") for (int k = 0; k < 2; ++k) dst[m][k] = *(const PG8_LAS bf16x8*)(lds + PG8_SA(b, h) + aoff + m * 2048 + k * 1024); } while (0)
#define PG8_LDB(dst, b, h) do { _Pragma("unroll") for (int n = 0; n < 2; ++n) _Pragma("unroll") for (int k = 0; k < 2; ++k) dst[n][k] = *(const PG8_LAS bf16x8*)(lds + PG8_SB(b, h) + boff + n * 2048 + k * 1024); } while (0)
#define PG8_MMA(ai, bj, At, Bt) do { __builtin_amdgcn_s_setprio(1); _Pragma("unroll") for (int m = 0; m < 4; ++m) _Pragma("unroll") for (int n = 0; n < 2; ++n) _Pragma("unroll") for (int k = 0; k < 2; ++k) \
        acc[ai][bj][m][n] = __builtin_amdgcn_mfma_f32_16x16x32_bf16(Bt[n][k], At[m][k], acc[ai][bj][m][n], 0, 0, 0); __builtin_amdgcn_s_setprio(0); } while (0)
#define PG8_WAIT_V(n) asm volatile("s_waitcnt vmcnt(" #n ")" ::: "memory")
#define PG8_WAIT_L(n) asm volatile("s_waitcnt lgkmcnt(" #n ")" ::: "memory")
#define PG8_BAR __builtin_amdgcn_s_barrier()
#define PG8_SCHED __builtin_amdgcn_sched_barrier(0)
#define PG8_SETVA(v, u) do { _Pragma("unroll") for (int _h = 0; _h < 2; ++_h) _Pragma("unroll") for (int _i = 0; _i < 2; ++_i) { \
        const int _row = _h * HALF + Rs[_i]; const unsigned _src = GATHER ? (unsigned)rows[(u).slot0 + _row] : (unsigned)_row; (v)[_h][_i] = (_src * (unsigned)lda + (unsigned)Cs[_i]) * 2u; } } while (0)
    Unit cur, nxt; int ui = 0;
    if (!S.next(0, cur)) return;
    f32x4 acc[2][2][4][2];
#pragma unroll
    for (int a = 0; a < 2; ++a)
#pragma unroll
        for (int b = 0; b < 2; ++b)
#pragma unroll
            for (int m = 0; m < 4; ++m)
#pragma unroll
                for (int n = 0; n < 2; ++n) acc[a][b][m][n] = (f32x4){0.f, 0.f, 0.f, 0.f};
    bf16x8 At[4][2], B0[2][2], B1[2][2];
    unsigned vc[2][2], vn[2][2];
    PG8_SETVA(vc, cur);
    const char* cA = cur.A; const char* cB = cur.B;
    PG8_STAGE(PG8_SB(0, 0), cB, voffB); PG8_STAGE(PG8_SB(0, 1), cB + hstepB, voffB); PG8_STAGE(PG8_SA(0, 0), cA, vc[0]); PG8_STAGE(PG8_SA(0, 1), cA, vc[1]);
    if (wr == 1) PG8_BAR;
    PG8_WAIT_V(2); PG8_BAR;
    PG8_STAGE(PG8_SB(1, 0), cB + kstep, voffB); PG8_STAGE(PG8_SA(1, 0), cA + kstep, vc[0]); PG8_STAGE(PG8_SB(1, 1), cB + hstepB + kstep, voffB);
    PG8_WAIT_V(6); PG8_BAR;
    for (;;) {
        const bool has_next = S.next(ui + 1, nxt);
        const char* nA = has_next ? nxt.A : cA; const char* nB = has_next ? nxt.B : cB;
        if (GATHER && has_next) { PG8_SETVA(vn, nxt); }
        else {
#pragma unroll
            for (int h = 0; h < 2; ++h)
#pragma unroll
                for (int i = 0; i < 2; ++i) vn[h][i] = vc[h][i]; }
        for (int t = 0; t < nt; t += 2) {
            const bool last = (t == nt - 2);
            const char* a1 = cA + (size_t)(t + 1) * kstep;
            const char* a2 = last ? nA : cA + (size_t)(t + 2) * kstep; const char* b2 = last ? nB : cB + (size_t)(t + 2) * kstep;
            const char* a3 = a2 + kstep; const char* b3 = b2 + kstep;
            unsigned v2[2][2];
#pragma unroll
            for (int h = 0; h < 2; ++h)
#pragma unroll
                for (int i = 0; i < 2; ++i) v2[h][i] = last ? vn[h][i] : vc[h][i];
            if constexpr (Epi::MIDK_T > 0) { if (t == Epi::MIDK_T) E.midk(acc, cur, wr, wc, fr, fq); }
            PG8_LDB(B0, 0, 0); PG8_LDB(B1, 0, 1); PG8_SCHED; PG8_LDA(At, 0, 0); PG8_STAGE(PG8_SA(1, 1), a1, vc[1]);
            PG8_WAIT_V(8); PG8_WAIT_L(0); PG8_BAR; PG8_MMA(0, 0, At, B0); PG8_MMA(0, 1, At, B1); PG8_BAR; PG8_SCHED;
            PG8_LDA(At, 0, 1); PG8_STAGE(PG8_SB(0, 0), b2, voffB); PG8_STAGE(PG8_SB(0, 1), b2 + hstepB, voffB); PG8_STAGE(PG8_SA(0, 0), a2, v2[0]);
            PG8_WAIT_V(8); PG8_WAIT_L(0); PG8_BAR; PG8_MMA(1, 0, At, B0); PG8_MMA(1, 1, At, B1); PG8_BAR; PG8_SCHED;
            PG8_LDB(B0, 1, 0); PG8_LDB(B1, 1, 1); PG8_SCHED; PG8_LDA(At, 1, 0); PG8_STAGE(PG8_SA(0, 1), a2, v2[1]);
            PG8_WAIT_V(8); PG8_WAIT_L(0); PG8_BAR; PG8_MMA(0, 0, At, B0); PG8_MMA(0, 1, At, B1); PG8_BAR; PG8_SCHED;
            PG8_LDA(At, 1, 1); PG8_STAGE(PG8_SB(1, 0), b3, voffB); PG8_STAGE(PG8_SB(1, 1), b3 + hstepB, voffB); PG8_STAGE(PG8_SA(1, 0), a3, v2[0]);
            PG8_WAIT_V(8); PG8_WAIT_L(0); PG8_BAR; PG8_MMA(1, 0, At, B0); PG8_MMA(1, 1, At, B1); PG8_BAR; PG8_SCHED;
        }
        if constexpr (ALIGN_EPI) { if (wr == 0) PG8_BAR; }
        E(acc, cur, wr, wc, fr, fq);
        if (!has_next) break;
#pragma unroll
        for (int a = 0; a < 2; ++a)
#pragma unroll
            for (int b = 0; b < 2; ++b)
#pragma unroll
                for (int m = 0; m < 4; ++m)
#pragma unroll
                    for (int n = 0; n < 2; ++n) acc[a][b][m][n] = (f32x4){0.f, 0.f, 0.f, 0.f};
        cur = nxt; cA = nA; cB = nB; ++ui;
#pragma unroll
        for (int h = 0; h < 2; ++h)
#pragma unroll
            for (int i = 0; i < 2; ++i) vc[h][i] = vn[h][i];
        if constexpr (ALIGN_EPI) { if (wr == 1) PG8_BAR; }
    }
    PG8_WAIT_V(0);
    if constexpr (!ALIGN_EPI) { if (wr == 0) PG8_BAR; }
    PG8_BAR;
#undef PG8_SA
#undef PG8_SB
#undef PG8_STAGE
#undef PG8_LDA
#undef PG8_LDB
#undef PG8_MMA
#undef PG8_SETVA
}

struct DenseOrder {
    const char* A; const char* B; size_t astep, bstep; int nM, nN, nwg, G, c;
    __device__ __forceinline__ void init(const void* A_, size_t astep_, const void* B_, size_t bstep_, int nM_, int nN_, int G_, int c_) { A = (const char*)A_; B = (const char*)B_; astep = astep_; bstep = bstep_; nM = nM_; nN = nN_; nwg = nM * nN; G = G_; c = c_; }
    __device__ __forceinline__ bool next(int i, Unit& u) const {
        const long L = (long)i * G + c; if (L >= nwg) return false;
        int wgid = (int)L; { const int q = nwg / NXCD, r = nwg % NXCD, xcd = wgid % NXCD, off = wgid / NXCD; wgid = (xcd < r ? xcd * (q + 1) : r * (q + 1) + (xcd - r) * q) + off; }
        const int nig = WGM * nN, gid = wgid / nig, fm = gid * WGM, gsz = (nM - fm) < WGM ? (nM - fm) : WGM;
        u.pm = fm + ((wgid % nig) % gsz); u.pn = (wgid % nig) / gsz; u.e = 0; u.slot0 = 0;
        u.A = A + (size_t)u.pm * astep; u.B = B + (size_t)u.pn * bstep; return true;
    }
};
}

namespace att {
typedef short bf16x8 __attribute__((ext_vector_type(8)));
typedef short s16x4 __attribute__((ext_vector_type(4)));
typedef float f32x16 __attribute__((ext_vector_type(16)));
typedef unsigned u32x4 __attribute__((ext_vector_type(4)));
typedef float f32x2_t __attribute__((ext_vector_type(2))); typedef __bf16 bf16x2_t __attribute__((ext_vector_type(2)));
typedef short v4i16_t __attribute__((ext_vector_type(4)));
typedef __attribute__((address_space(3))) const char* lds_cptr;
constexpr int SLOTB = 16384, NTILE = 257;
constexpr int LDS_K = 0, LDS_V = 3 * SLOTB, LDS_Q = 6 * SLOTB, LDS_WS = 131072 + 1024, LDS_LUT = LDS_WS + 2048, LDS_END = LDS_LUT + 1024;
constexpr int LDS_EX = 0, EXPITCH = 132, LDS_STG = 4 * 32 * EXPITCH * 4;
static_assert(LDS_STG + 4 * 8192 <= 131072, "attention epilogue overlay stays inside the ring region");
__device__ __forceinline__ int crow(int r, int hi) { return (r & 3) + 8 * (r >> 2) + 4 * hi; }
#define SBAR() __builtin_amdgcn_sched_barrier(0)
__device__ __forceinline__ void glds16(const void* gsrc, unsigned lds_dst) { unsigned keep;
    asm volatile("s_mov_b32 %0, m0\n\ts_mov_b32 m0, %2\n\ts_nop 0\n\tglobal_load_lds_dwordx4 %1, off\n\ts_mov_b32 m0, %0" : "=&s"(keep) : "v"(gsrc), "s"(lds_dst) : "memory"); }
__device__ __forceinline__ unsigned cvtpk_s(float lo, float hi) { f32x2_t v = {lo, hi}; bf16x2_t b = __builtin_convertvector(v, bf16x2_t); return __builtin_bit_cast(unsigned, b); }
#define WAIT_BAR(N) asm volatile("s_waitcnt vmcnt(" #N ") lgkmcnt(0)\n\ts_barrier" ::: "memory")
__device__ __forceinline__ void kload8(bf16x8* kf, lds_cptr kp) {
    kf[0] = *(const __attribute__((address_space(3))) bf16x8*)(kp);        kf[1] = *(const __attribute__((address_space(3))) bf16x8*)(kp + 512);
    kf[2] = *(const __attribute__((address_space(3))) bf16x8*)(kp + 2048); kf[3] = *(const __attribute__((address_space(3))) bf16x8*)(kp + 2560);
    kf[4] = *(const __attribute__((address_space(3))) bf16x8*)(kp + 4096); kf[5] = *(const __attribute__((address_space(3))) bf16x8*)(kp + 4608);
    kf[6] = *(const __attribute__((address_space(3))) bf16x8*)(kp + 6144); kf[7] = *(const __attribute__((address_space(3))) bf16x8*)(kp + 6656);
}
__device__ __forceinline__ void kload2(bf16x8* kf, lds_cptr kp, int j) { kf[2 * j] = *(const __attribute__((address_space(3))) bf16x8*)(kp + j * 2048); kf[2 * j + 1] = *(const __attribute__((address_space(3))) bf16x8*)(kp + j * 2048 + 512); }
__device__ __forceinline__ s16x4 vtr(lds_cptr p) { return __builtin_bit_cast(s16x4, __builtin_amdgcn_ds_read_tr16_b64_v4i16((__attribute__((address_space(3))) v4i16_t*)p)); }

__device__ __forceinline__ void add_bias(f32x16& C0, f32x16& C1, int s, int qrow, int hi, const __attribute__((address_space(3))) float* lutl) {
#pragma unroll
    for (int r = 0; r < 16; ++r) {
#pragma unroll
        for (int half = 0; half < 2; ++half) {
            const int kk = crow(r, hi) + 32 * half;
            float add;
            if (s == NTILE - 1) { int rel = kk - 16 - qrow; rel = rel < -91 ? -91 : rel; add = kk < NMETA ? lutl[rel + 91] : -INFINITY; }
            else { int rel = 64 * s + kk - qrow; rel = rel < -91 ? -91 : (rel > 91 ? 91 : rel); add = lutl[rel + 91]; }
            if (half == 0) C0[r] += add; else C1[r] += add;
        }
    }
}

__device__ __forceinline__ void attn_unit(int h, int qb, const bf16_t* Q, const bf16_t* __restrict__ K, const bf16_t* __restrict__ V, bf16_t* CAT, char* shm, float lam, const float* subln, float f1) {
    const int tid = threadIdx.x, lane = tid & 63, r32 = lane & 31, hi = lane >> 5; const int wid = __builtin_amdgcn_readfirstlane(tid >> 6);
    const int c = wid >> 2, wq = wid & 3;
    const int q0 = qb * 128, qrow = q0 + wq * 32 + r32;
    const unsigned lds0 = (unsigned)(uintptr_t)shm;
    const lds_cptr shm3 = (lds_cptr)shm;
    float* wsf = (float*)(shm + LDS_WS) + wid * 64;
    const __attribute__((address_space(3))) float* lutl = (const __attribute__((address_space(3))) float*)((lds_cptr)shm + LDS_LUT);
    const bf16_t* ksrc = K + (size_t)lane * QKW + h * 128 + wid * 8;
    const bf16_t* vsrc = V + (size_t)(16 * (wid & 3) + (lane >> 2)) * QKW + h * 128 + (wid >> 2) * 32 + (lane & 3) * 8;
    const unsigned kdst = lds0 + LDS_K + wid * 1024, vdst = lds0 + LDS_V + (wid >> 2) * 4096 + (wid & 3) * 1024;
#define TCL(t) ((t) < NTILE ? (t) : NTILE - 1)
#define DMA_K(t, slot) do { const bf16_t* _p = ksrc + (size_t)TCL(t) * 64 * QKW; glds16(_p, (unsigned)__builtin_amdgcn_readfirstlane(kdst + (slot))); glds16(_p + 64, (unsigned)__builtin_amdgcn_readfirstlane(kdst + 8192 + (slot))); } while (0)
#define DMA_V(t, slot) do { const bf16_t* _p = vsrc + (size_t)TCL(t) * 64 * QKW; glds16(_p, (unsigned)__builtin_amdgcn_readfirstlane(vdst + (slot))); glds16(_p + 64, (unsigned)__builtin_amdgcn_readfirstlane(vdst + 8192 + (slot))); } while (0)
    const lds_cptr kp0 = shm3 + LDS_K + c * 8192 + hi * 1024 + r32 * 16;
    const lds_cptr vp0 = shm3 + LDS_V + ((lane >> 4) & 1) * 32 + (lane & 3) * 8 + (4 * hi + ((lane & 15) >> 2)) * 64;
    const int near_lo = (2 * qb - 2) < 0 ? 0 : 2 * qb - 2, near_hi = (2 * qb + 3) > 255 ? 255 : 2 * qb + 3;
#define NEAR(s) (((s) >= near_lo && (s) <= near_hi) || (s) == NTILE - 1)
    DMA_K(0, 0); DMA_V(0, 0); DMA_K(1, SLOTB); DMA_K(2, 2 * SLOTB);
    { const bf16_t* Qw = Q + (size_t)(q0 + wq * 32 + (lane & 31)) * QKW + h * 128 + c * 64 + (lane >> 5) * 8;
      const unsigned qdst = lds0 + LDS_Q + wid * 4096;
#pragma unroll
      for (int p = 0; p < 4; ++p) glds16(Qw + p * 16, (unsigned)__builtin_amdgcn_readfirstlane(qdst + p * 1024)); }
    const lds_cptr qp0 = shm3 + LDS_Q + wid * 4096 + hi * 512 + r32 * 16;
#define QF(d0) (*(const __attribute__((address_space(3))) bf16x8*)(qp0 + (d0) * 1024))
    float l_reg = 0.f; f32x16 o[4]; o[0] = f32x16{}; o[1] = f32x16{}; o[2] = f32x16{}; o[3] = f32x16{};
    const f32x16 zero16 = f32x16{};
    f32x16 pA0, pA1, pB0, pB1; bf16x8 kf[8]; bf16x8 qfa, qfb;
    int sl_prev = 0, sl_cur = 0, sl_next = SLOTB;
#define ROT() do { sl_prev = sl_cur; sl_cur = sl_next; sl_next = (sl_next == 2 * SLOTB) ? 0 : sl_next + SLOTB; } while (0)
    WAIT_BAR(0);
    kload8(kf, kp0);
#pragma unroll
    for (int d0 = 0; d0 < 4; ++d0) { pA0 = __builtin_amdgcn_mfma_f32_32x32x16_bf16(kf[2 * d0], QF(d0), d0 == 0 ? zero16 : pA0, 0, 0, 0); pA1 = __builtin_amdgcn_mfma_f32_32x32x16_bf16(kf[2 * d0 + 1], QF(d0), d0 == 0 ? zero16 : pA1, 0, 0, 0); }
    if (NEAR(0)) add_bias(pA0, pA1, 0, qrow, hi, lutl);
#pragma unroll
    for (int r = 0; r < 16; ++r) { pA0[r] = __builtin_amdgcn_exp2f(pA0[r]); pA1[r] = __builtin_amdgcn_exp2f(pA1[r]); }
    WAIT_BAR(0);
    DMA_K(3, 0); DMA_V(1, SLOTB);
    ROT();
    kload8(kf, kp0 + sl_cur); qfa = QF(0);
    WAIT_BAR(4);
    s16x4 vlo[16], vhi[16]; u32x4 pw0, pw1, pw2, pw3;
#define PKW(P, B) cvtpk_s(P[B], P[B + 1])
#define PAF(k) __builtin_bit_cast(bf16x8, pw##k)
#define VFR(i) (bf16x8){vlo[i][0], vlo[i][1], vlo[i][2], vlo[i][3], vhi[i][0], vhi[i][1], vhi[i][2], vhi[i][3]}
#define PIN(x) asm volatile("" : "+v"(x))
#define GAPA(MF, A0, A1, A2, A3, W0, W1, PW) do { MF; sacc += A0; sacc += A1; sacc += A2; sacc += A3; PIN(sacc); W0; W1; PIN(PW); SBAR(); } while (0)
#define EX(v) __builtin_amdgcn_exp2f(v)
#define VRD(i) do { vlo[i] = vtr(vp_ + (((i) >> 2) * 4096 + ((i) & 3) * 1024)); vhi[i] = vtr(vp_ + (((i) >> 2) * 4096 + ((i) & 3) * 1024 + 512)); SBAR(); } while (0)
#define KRD(j) do { kload2(kf, kp0 + sl_next, j); SBAR(); } while (0)
#define MF32 __builtin_amdgcn_mfma_f32_32x32x16_bf16
#define PVG(id, X, B, nid) do { o[(id) >> 2] = MF32(PAF_((id) & 3), VFR(id), o[(id) >> 2], 0, 0, 0); X[B] = EX(X[B]); X[B + 1] = EX(X[B + 1]); PIN(X); SBAR(); if ((nid) >= 0) VRD((nid) < 0 ? 0 : (nid)); } while (0)
#define PAF_(k) ((k) == 0 ? PAF(0) : (k) == 1 ? PAF(1) : (k) == 2 ? PAF(2) : PAF(3))
#define STEP(C0, C1, P0, P1, s) do { SBAR(); \
    const lds_cptr vp_ = vp0 + sl_prev; \
    float sacc = (P0[0] + P0[1]); \
    GAPA(C0 = MF32(kf[0], qfa, zero16, 0, 0, 0); qfb = QF(1), P0[2], P0[3], P0[4], P0[5],     pw0[0] = PKW(P0, 0), pw0[1] = PKW(P0, 2), pw0); \
    GAPA(C1 = MF32(kf[1], qfa, zero16, 0, 0, 0), P0[6], P0[7], P0[8], P0[9],     pw0[2] = PKW(P0, 4), pw0[3] = PKW(P0, 6), pw0); \
    GAPA(C0 = MF32(kf[2], qfb, C0, 0, 0, 0); qfa = QF(2),   P0[10], P0[11], P0[12], P0[13], pw1[0] = PKW(P0, 8), pw1[1] = PKW(P0, 10), pw1); \
    GAPA(C1 = MF32(kf[3], qfb, C1, 0, 0, 0),   P0[14], P0[15], P1[0], P1[1],   pw1[2] = PKW(P0, 12), pw1[3] = PKW(P0, 14), pw1); \
    VRD(0); GAPA(C0 = MF32(kf[4], qfa, C0, 0, 0, 0); qfb = QF(3),   P1[2], P1[3], P1[4], P1[5],     pw2[0] = PKW(P1, 0), pw2[1] = PKW(P1, 2), pw2); \
    VRD(4); GAPA(C1 = MF32(kf[5], qfa, C1, 0, 0, 0),   P1[6], P1[7], P1[8], P1[9],     pw2[2] = PKW(P1, 4), pw2[3] = PKW(P1, 6), pw2); \
    VRD(1); GAPA(C0 = MF32(kf[6], qfb, C0, 0, 0, 0),   P1[10], P1[11], P1[12], P1[13], pw3[0] = PKW(P1, 8), pw3[1] = PKW(P1, 10), pw3); \
    VRD(5); GAPA(C1 = MF32(kf[7], qfb, C1, 0, 0, 0),   P1[14], P1[15], 0.f, 0.f,       pw3[2] = PKW(P1, 12), pw3[3] = PKW(P1, 14), pw3); \
    l_reg += sacc; \
    DMA_K((s) + 3, sl_cur); DMA_V((s) + 1, sl_next); \
    if (NEAR(s)) add_bias(C0, C1, (s), qrow, hi, lutl); \
    SBAR(); \
    PVG(0, C0, 0, 2);   PVG(4, C0, 2, 6);   PVG(1, C0, 4, 3);   PVG(5, C0, 6, 7); \
    PVG(2, C0, 8, 8);   PVG(6, C0, 10, 12); PVG(3, C0, 12, 9);  PVG(7, C0, 14, 13); \
    PVG(8, C1, 0, 10);  PVG(12, C1, 2, 14); \
    KRD(0); PVG(9, C1, 4, 11);  KRD(1); PVG(13, C1, 6, 15); \
    KRD(2); PVG(10, C1, 8, -1); KRD(3); PVG(14, C1, 10, -1); \
    PVG(11, C1, 12, -1); qfa = QF(0); SBAR(); PVG(15, C1, 14, -1); \
    if ((s) == near_lo && near_lo > 0) { l_reg *= f1; _Pragma("unroll") for (int d_ = 0; d_ < 4; ++d_) _Pragma("unroll") for (int r = 0; r < 16; ++r) o[d_][r] *= f1; } \
    } while (0)
    for (int s = 1; s + 1 < NTILE; s += 2) {
        STEP(pB0, pB1, pA0, pA1, s);     WAIT_BAR(4); ROT();
        STEP(pA0, pA1, pB0, pB1, s + 1); WAIT_BAR(4); ROT();
    }
    { float sacc = pA0[0] + pA0[1];
#pragma unroll
      for (int r = 2; r < 16; ++r) sacc += pA0[r];
#pragma unroll
      for (int r = 0; r < 16; ++r) sacc += pA1[r];
      l_reg += sacc;
      pw0 = (u32x4){PKW(pA0, 0), PKW(pA0, 2), PKW(pA0, 4), PKW(pA0, 6)}; pw1 = (u32x4){PKW(pA0, 8), PKW(pA0, 10), PKW(pA0, 12), PKW(pA0, 14)};
      pw2 = (u32x4){PKW(pA1, 0), PKW(pA1, 2), PKW(pA1, 4), PKW(pA1, 6)}; pw3 = (u32x4){PKW(pA1, 8), PKW(pA1, 10), PKW(pA1, 12), PKW(pA1, 14)};
      SBAR();
      const lds_cptr vp_ = vp0 + sl_prev;
#pragma unroll
      for (int d0 = 0; d0 < 4; ++d0) {
          s16x4 lo[4], hh[4];
#pragma unroll
          for (int ks = 0; ks < 4; ++ks) { lo[ks] = vtr(vp_ + (d0 * 4096 + ks * 1024)); hh[ks] = vtr(vp_ + (d0 * 4096 + ks * 1024 + 512)); }
#define PK_(k) (bf16x8){lo[k][0], lo[k][1], lo[k][2], lo[k][3], hh[k][0], hh[k][1], hh[k][2], hh[k][3]}
          o[d0] = MF32(PAF(0), PK_(0), o[d0], 0, 0, 0); o[d0] = MF32(PAF(1), PK_(1), o[d0], 0, 0, 0);
          o[d0] = MF32(PAF(2), PK_(2), o[d0], 0, 0, 0); o[d0] = MF32(PAF(3), PK_(3), o[d0], 0, 0, 0);
#undef PK_
      } }
    int lane_e = lane; asm volatile("" : "+v"(lane_e));
    const int r32e = lane_e & 31, hie = lane_e >> 5;
    { auto rr = __builtin_amdgcn_permlane32_swap(__float_as_uint(l_reg), __float_as_uint(l_reg), false, false); l_reg = __uint_as_float(rr[0]) + __uint_as_float(rr[1]); }
    if (hie == 0) wsf[r32e] = l_reg;
    asm volatile("s_waitcnt lgkmcnt(0)" ::: "memory");
    float rli[16];
    { const float sc = c ? lam : 1.0f;
#pragma unroll
      for (int r = 0; r < 16; ++r) rli[r] = sc * __builtin_amdgcn_rcpf(wsf[crow(r, hie)]); }
    WAIT_BAR(0);
    float* ex = (float*)(shm + LDS_EX) + wq * 32 * EXPITCH;
    if (c == 1) {
#pragma unroll
        for (int r = 0; r < 16; ++r)
#pragma unroll
            for (int d0 = 0; d0 < 4; ++d0) ex[crow(r, hie) * EXPITCH + d0 * 32 + r32e] = o[d0][r] * rli[r];
    }
    WAIT_BAR(0);
    if (c == 0) {
        bf16_t* stg = (bf16_t*)(shm + LDS_STG) + wq * 4096;
        float sg[4];
#pragma unroll
        for (int d0 = 0; d0 < 4; ++d0) sg[d0] = subln[d0 * 32 + r32e] * 0.8f;
#pragma unroll
        for (int r = 0; r < 16; ++r) {
            float v[4], ss = 0.f;
#pragma unroll
            for (int d0 = 0; d0 < 4; ++d0) { v[d0] = o[d0][r] * rli[r] - ex[crow(r, hie) * EXPITCH + d0 * 32 + r32e]; ss += v[d0] * v[d0]; }
            ss += __shfl_xor(ss, 1); ss += __shfl_xor(ss, 2); ss += __shfl_xor(ss, 4); ss += __shfl_xor(ss, 8); ss += __shfl_xor(ss, 16);
            const float rn = rsqrtf(ss * (1.0f / DV) + EPS);
#pragma unroll
            for (int d0 = 0; d0 < 4; ++d0) stg[crow(r, hie) * 128 + d0 * 32 + r32e] = f2bf(v[d0] * rn * sg[d0]);
        }
        asm volatile("s_waitcnt lgkmcnt(0)" ::: "memory");
        bf16_t* Ow = CAT + (size_t)(q0 + wq * 32) * DM + SSMW + h * DV;
#pragma unroll
        for (int i = 0; i < 8; ++i) { const int row = i * 4 + (lane_e >> 4), ch = lane_e & 15; const u32x4 v = *(const u32x4*)(stg + row * 128 + ch * 8); *(u32x4*)(Ow + (size_t)row * DM + ch * 8) = v; }
    }
    WAIT_BAR(0);
#undef TCL
#undef DMA_K
#undef DMA_V
#undef NEAR
#undef ROT
#undef PKW
#undef PAF
#undef VFR
#undef PIN
#undef GAPA
#undef EX
#undef VRD
#undef PVG
#undef PAF_
#undef KRD
#undef MF32
#undef QF
#undef STEP
}
#undef SBAR
#undef WAIT_BAR
}

#define GAS __attribute__((address_space(1)))
#define LAS __attribute__((address_space(3)))
#define XB_TMO      128
#define XB_XCNT(j)  (256  + 64 * (j))
#define XB_XSUB(j)  (1280 + 64 * (j))
#define XB_XGEN(j)  (2304 + 64 * (j))
#define XB_TOP      3328
#define XB_TOPGEN   3392
#define XCD_BAR_WORDS 3456
#define XB_SPIN_CAP (1u << 18)
__device__ __forceinline__ unsigned xb_ld(unsigned* p)              { return __hip_atomic_load(p, __ATOMIC_RELAXED, __HIP_MEMORY_SCOPE_AGENT); }
__device__ __forceinline__ unsigned xb_add(unsigned* p, unsigned v) { return __hip_atomic_fetch_add(p, v, __ATOMIC_RELAXED, __HIP_MEMORY_SCOPE_AGENT); }
__device__ __forceinline__ unsigned xb_xcc_id() { return (unsigned)__builtin_amdgcn_s_getreg((3 << 11) | 20) & 0xFu; }
#define XB_SPIN(cond, bar) do { unsigned _sp = 0; while (cond) { __builtin_amdgcn_s_sleep(1); \
    if ((++_sp & 255u) == 0u) { if (xb_ld(&(bar)[XB_TMO])) break; if (_sp > XB_SPIN_CAP) { atomicAdd(&(bar)[XB_TMO], 1u); break; } } } } while (0)
struct XcdBarrier { unsigned* bar; unsigned x; volatile LAS unsigned* st; };
__device__ __forceinline__ XcdBarrier xcd_barrier_post(unsigned* bar, volatile LAS unsigned* st) {
    XcdBarrier b; b.bar = bar; b.x = xb_xcc_id(); b.st = st;
    if (threadIdx.x == 0) (void)xb_add(&bar[XB_XCNT(b.x)], 1u);
    return b;
}
__device__ __forceinline__ void xcd_barrier_complete(unsigned* bar, unsigned x, unsigned& nloc, unsigned& nx) {
    const unsigned G = gridDim.x * gridDim.y * gridDim.z;
    unsigned sum, cnt, mine, sp = 0u;
    for (;;) {
        sum = 0u; cnt = 0u; mine = 0u;
#pragma unroll
        for (unsigned j = 0; j < 16; ++j) { const unsigned c = xb_ld(&bar[XB_XCNT(j)]); sum += c; cnt += (c > 0u) ? 1u : 0u; mine = (j == x) ? c : mine; }
        if (sum == G) break;
        __builtin_amdgcn_s_sleep(1);
        if ((++sp & 255u) == 0u) { if (xb_ld(&bar[XB_TMO])) break; if (sp > XB_SPIN_CAP) { atomicAdd(&bar[XB_TMO], 1u); break; } }
    }
    nloc = mine > 0u ? mine : 1u; nx = cnt > 0u ? cnt : 1u;
}
__device__ __forceinline__ void xcd_barrier(const XcdBarrier& b) {
    asm volatile("s_waitcnt vmcnt(0)" ::: "memory");
    __syncthreads();
    if (threadIdx.x == 0) {
        unsigned* bar = b.bar;
        __builtin_amdgcn_s_waitcnt(0);
        unsigned nloc = b.st[0], nx = b.st[1];
        if (nloc == 0u) { xcd_barrier_complete(bar, b.x, nloc, nx); b.st[0] = nloc; b.st[1] = nx; }
        const unsigned old = xb_add(&bar[XB_XSUB(b.x)], 1u);
        const unsigned gen = old / nloc;
        if (old + 1u == (gen + 1u) * nloc) {
            __builtin_amdgcn_fence(__ATOMIC_RELEASE, "agent");
            asm volatile("s_waitcnt vmcnt(0)" ::: "memory");
            const unsigned og = xb_add(&bar[XB_TOP], 1u);
            const unsigned tg = og / nx;
            if (og + 1u == (tg + 1u) * nx) xb_add(&bar[XB_TOPGEN], 1u);
            else XB_SPIN(xb_ld(&bar[XB_TOPGEN]) == tg, bar);
            __builtin_amdgcn_fence(__ATOMIC_ACQUIRE, "agent");
            xb_add(&bar[XB_XGEN(b.x)], 1u);
            asm volatile("s_waitcnt vmcnt(0)" ::: "memory");
        } else {
            XB_SPIN(xb_ld(&bar[XB_XGEN(b.x)]) == gen, bar);
            __builtin_amdgcn_fence(__ATOMIC_ACQUIRE, "agent");
            asm volatile("s_waitcnt vmcnt(0)" ::: "memory");
        }
    }
    __syncthreads();
}

constexpr int NWAVES = 8;
constexpr int RING_BYTES = 131072, LDSCTL_OFF = RING_BYTES, MISC_OFF = LDSCTL_OFF + 320, LDS_BYTES = 147456;
struct Frame { LAS unsigned char* lds; int tid, lane, wave, vcu, G; unsigned char* ws; };

DEV int colmap(int map, int c) {
    if (map == 1) { const int ct = c & 255; return (c & ~255) + 128 * ((ct >> 5) & 1) + 32 * (ct >> 6) + (ct & 31); }
    if (map == 2) return 256 * (c >> 7) + (c & 127);
    if (map == 3) return 256 * (c >> 7) + 128 + (c & 127);
    return c;
}
DEV unsigned pk2(float lo, float hi) { return (unsigned)f2bf(lo) | ((unsigned)f2bf(hi) << 16); }
DEV void p0_transpose_item(const float* W, int ldw, int N, const float* kgain, bf16_t* WT, int ldt, int koff, int map, LAS float* scr, int item, int lane) {
    const int nblk = N / 32, kb = item / nblk, nb = item % nblk, k0 = 64 * kb, n0 = 32 * nb;
#pragma unroll 8
    for (int i = 0; i < 32; ++i) { const int kk = 2 * i + (lane >> 5); const float g = kgain ? kgain[k0 + kk] : 1.0f; scr[kk * 33 + (lane & 31)] = g * W[(size_t)(k0 + kk) * ldw + n0 + (lane & 31)]; }
    asm volatile("s_waitcnt lgkmcnt(0)" ::: "memory");
    const int c = lane & 7;
#pragma unroll
    for (int j = 0; j < 4; ++j) { const int n = (lane >> 3) + 8 * j; const LAS float* s = scr + (8 * c) * 33 + n;
        uint4 o; o.x = pk2(s[0 * 33], s[1 * 33]); o.y = pk2(s[2 * 33], s[3 * 33]); o.z = pk2(s[4 * 33], s[5 * 33]); o.w = pk2(s[6 * 33], s[7 * 33]);
        *(uint4*)(WT + (size_t)colmap(map, n0 + n) * ldt + koff + k0 + 8 * c) = o; }
    asm volatile("s_waitcnt lgkmcnt(0)" ::: "memory");
}
DEV void p0_meta_proj(const In& in, unsigned char* ws, int grp, int lane) {
    const int col = QKW + grp * 64 + lane;
    float acc[NMETA];
#pragma unroll
    for (int j = 0; j < NMETA; ++j) acc[j] = 0.f;
    float ssx[NMETA];
#pragma unroll
    for (int j = 0; j < NMETA; ++j) ssx[j] = 0.f;
    for (int k = 0; k < DM; ++k) {
        const float w = in.w_in[(size_t)k * INW + col] * in.norm_mix[k];
#pragma unroll
        for (int j = 0; j < NMETA; ++j) { const float xm = in.meta[(size_t)j * DM + k]; acc[j] += xm * w; ssx[j] += xm * xm; }
    }
#pragma unroll
    for (int j = 0; j < NMETA; ++j) {
        const float v = acc[j] * rsqrtf(ssx[j] * (1.0f / DM) + EPS);
        const int row = T + j;
        if (grp < 16) { const float r = rsqrtf(wave_sum(v * v) * (1.0f / 64.0f) + EPS); ((bf16_t*)(ws + WS_K))[(size_t)row * QKW + grp * 64 + lane] = f2bf(v * r * in.k_norm[lane]); }
        else if (grp < 32) ((bf16_t*)(ws + WS_V))[(size_t)row * QKW + (grp - 16) * 64 + lane] = f2bf(v);
        else ((float*)(ws + WS_CTL + C_UMETA))[(size_t)j * SSMW + (grp - 32) * 64 + lane] = v;
    }
}
DEV void p0_prologue(Frame& F, const In& in) {
    unsigned char* ws = F.ws;
    LAS float* scr = (LAS float*)(F.lds + F.wave * 16384);
    const int gw = F.vcu * NWAVES + F.wave, NGW = F.G * NWAVES;
    constexpr int I_IN = (DM / 64) * (INW / 32), I_GLU = (SSMW / 64) * (SSMW / 32), I_OUTH = (SSMW / 64) * (DM / 32), I_SHG = (DM / 64) * (SH / 32), I_SHD = (SH / 64) * (DM / 32);
    constexpr int I_EG = (DM / 64) * (EH / 32), I_ED = (EH / 64) * (DM / 32);
    constexpr int NITEMS = I_IN + I_GLU + 2 * I_OUTH + 2 * I_SHG + I_SHD + NE * (2 * I_EG + I_ED);
    for (int it = gw; it < NITEMS; it += NGW) {
        int r = it;
        if (r < I_IN) { p0_transpose_item(in.w_in, INW, INW, in.norm_mix, (bf16_t*)(ws + WS_WT_IN), DM, 0, 1, scr, r, F.lane); continue; } r -= I_IN;
        if (r < I_GLU) { p0_transpose_item(in.w_glu, SSMW, SSMW, nullptr, (bf16_t*)(ws + WS_WT_GLU), SSMW, 0, 0, scr, r, F.lane); continue; } r -= I_GLU;
        if (r < I_OUTH) { p0_transpose_item(in.w_out + (size_t)SSMW * DM, DM, DM, in.ssm_norm, (bf16_t*)(ws + WS_WT_OUT), DM, 0, 0, scr, r, F.lane); continue; } r -= I_OUTH;
        if (r < I_OUTH) { p0_transpose_item(in.w_out, DM, DM, nullptr, (bf16_t*)(ws + WS_WT_OUT), DM, SSMW, 0, scr, r, F.lane); continue; } r -= I_OUTH;
        if (r < I_SHG) { p0_transpose_item(in.sh_gate, SH, SH, in.norm_ffn, (bf16_t*)(ws + WS_WT_SHGU), DM, 0, 2, scr, r, F.lane); continue; } r -= I_SHG;
        if (r < I_SHG) { p0_transpose_item(in.sh_up, SH, SH, in.norm_ffn, (bf16_t*)(ws + WS_WT_SHGU), DM, 0, 3, scr, r, F.lane); continue; } r -= I_SHG;
        if (r < I_SHD) { p0_transpose_item(in.sh_down, DM, DM, nullptr, (bf16_t*)(ws + WS_WT_SHD), SH, 0, 0, scr, r, F.lane); continue; } r -= I_SHD;
        { const int per = 2 * I_EG + I_ED, e = r / per; int q = r % per;
          if (q < I_EG) { p0_transpose_item(in.w_gate + (size_t)e * DM * EH, EH, EH, in.norm_ffn, (bf16_t*)(ws + WS_WGU) + (size_t)e * 1024 * DM, DM, 0, 2, scr, q, F.lane); continue; } q -= I_EG;
          if (q < I_EG) { p0_transpose_item(in.w_up + (size_t)e * DM * EH, EH, EH, in.norm_ffn, (bf16_t*)(ws + WS_WGU) + (size_t)e * 1024 * DM, DM, 0, 3, scr, q, F.lane); continue; } q -= I_EG;
          p0_transpose_item(in.w_down + (size_t)e * EH * DM, DM, DM, nullptr, (bf16_t*)(ws + WS_WDN) + (size_t)e * DM * EH, EH, 0, 0, scr, q, F.lane); }
    }
    for (int row = gw; row < T; row += NGW) {
        const float* src = in.x + (size_t)row * DM; bf16_t* dst = (bf16_t*)(ws + WS_XB) + (size_t)row * DM; float ss = 0.f;
#pragma unroll
        for (int j = 0; j < DM / 256; ++j) { const float4 v = *(const float4*)(src + j * 256 + F.lane * 4); ss += v.x * v.x + v.y * v.y + v.z * v.z + v.w * v.w;
            uint2 o; o.x = pk2(v.x, v.y); o.y = pk2(v.z, v.w); *(uint2*)(dst + j * 256 + F.lane * 4) = o; }
        ss = wave_sum(ss); if (F.lane == 0) ((float*)(ws + WS_CTL + C_RSTDX))[row] = rsqrtf(ss * (1.0f / DM) + EPS);
    }
    for (int gq = NGW - 1 - gw; gq < 48; gq += NGW) p0_meta_proj(in, ws, gq, F.lane);
    {
        const int tid = gw * 64 + F.lane, nthr = NGW * 64;
        float* lut = (float*)(ws + WS_CTL + C_LUT);
        for (int i = tid; i < NH * LUTN; i += nthr) { const int h = i / LUTN, rel = i % LUTN - 91; lut[i] = in.rel_bias[t5_bucket(rel) * NH + h] * LOG2E; }
        if (tid == 0) { float s1 = 0.f, s2 = 0.f; for (int i = 0; i < HD; ++i) { s1 += in.lam_q1[i] * in.lam_k1[i]; s2 += in.lam_q2[i] * in.lam_k2[i]; } *(float*)(ws + WS_CTL + C_LAM) = expf(s1) - expf(s2) + 0.2f; }
        float* abar = (float*)(ws + WS_CTL + C_SSMP); float* bbar = abar + 2 * 64 * 64 * 2;
        for (int i = tid; i < 2 * NG * NST; i += nthr) {
            const int dg = i / NST; const float are = in.a_re[i], aim = in.a_im[i], dt = expf(in.log_step[dg]);
            const float decay = expf(are * dt); float sn, cs; sincosf(aim * dt, &sn, &cs);
            const float abr = decay * cs, abi = decay * sn, den = are * are + aim * aim, zr = abr - 1.0f;
            const float fre = (zr * are + abi * aim) / den, fim = (abi * are - zr * aim) / den;
            abar[i * 2] = abr; abar[i * 2 + 1] = abi;
            for (int p = 0; p < GP; ++p) { const float br = in.b_re[(size_t)i * GP + p], bi = in.b_im[(size_t)i * GP + p];
                bbar[((size_t)i * GP + p) * 2] = fre * br - fim * bi; bbar[((size_t)i * GP + p) * 2 + 1] = fre * bi + fim * br; }
        }
        bf16_t* Kb = (bf16_t*)(ws + WS_K); bf16_t* Vb = (bf16_t*)(ws + WS_V);
        for (int i = tid; i < (KROWS - LTOT) * QKW; i += nthr) { Kb[(size_t)LTOT * QKW + i] = 0; Vb[(size_t)LTOT * QKW + i] = 0; }
        float* WR = (float*)(ws + WS_WR);
        for (int i = tid; i < DM * NE; i += nthr) WR[i] = in.norm_ffn[i >> 6] * in.router_w[i];
    }
}

struct EpiInProjF {
    static constexpr int MIDK_T = 0;
    unsigned char* ws; const float* qn; const float* kn;
    __device__ __forceinline__ void midk(pg8::f32x4 (&)[2][2][4][2], const pg8::Unit&, int, int, int, int) const {}
    __device__ __forceinline__ void operator()(const pg8::f32x4 (&acc)[2][2][4][2], const pg8::Unit& u, int wr, int wc, int fr, int fq) const {
        using namespace pg8;
        const int kind = u.pn >> 2;
        const int row0 = u.pm * BM + wr * 64 + fr;
        const int ct0 = (u.pn & 3) * 256 + 64 * wc + 8 * fq;
        const float* rstd = (const float*)(ws + WS_CTL + C_RSTDX);
        float gn[2][8];
        if (kind < 2) { const float* gsrc = kind == 0 ? qn : kn;
#pragma unroll
            for (int bj = 0; bj < 2; ++bj)
#pragma unroll
                for (int j = 0; j < 8; ++j) gn[bj][j] = gsrc[32 * bj + 8 * fq + j] * (kind == 0 ? C2 : 1.0f); }
#pragma unroll
        for (int ai = 0; ai < 2; ++ai)
#pragma unroll
            for (int m = 0; m < 4; ++m) {
                const int row = row0 + ai * HALF + m * 16; const float rs = rstd[row];
                f32x4 v[2][2]; float ss = 0.f;
#pragma unroll
                for (int bj = 0; bj < 2; ++bj)
#pragma unroll
                    for (int n = 0; n < 2; ++n) { v[bj][n] = acc[ai][bj][m][n] * rs; ss += (v[bj][n][0] * v[bj][n][0] + v[bj][n][1] * v[bj][n][1]) + (v[bj][n][2] * v[bj][n][2] + v[bj][n][3] * v[bj][n][3]); }
                if (kind < 2) { ss += __shfl_xor(ss, 16); ss += __shfl_xor(ss, 32); const float r = rsqrtf(ss * (1.0f / 64.0f) + EPS);
#pragma unroll
                    for (int bj = 0; bj < 2; ++bj)
#pragma unroll
                        for (int n = 0; n < 2; ++n)
#pragma unroll
                            for (int j = 0; j < 4; ++j) v[bj][n][j] *= r * gn[bj][4 * n + j]; }
#pragma unroll
                for (int bj = 0; bj < 2; ++bj) {
                    u32x4 w; w.x = cvt_pk_bf16(v[bj][0][0], v[bj][0][1]); w.y = cvt_pk_bf16(v[bj][0][2], v[bj][0][3]); w.z = cvt_pk_bf16(v[bj][1][0], v[bj][1][1]); w.w = cvt_pk_bf16(v[bj][1][2], v[bj][1][3]);
                    const int cc = ct0 + 32 * bj;
                    if (kind == 0) *(u32x4*)((bf16_t*)(ws + WS_Q) + (size_t)row * QKW + cc) = w;
                    else if (kind == 1) *(u32x4*)((bf16_t*)(ws + WS_K) + (size_t)row * QKW + cc) = w;
                    else if (kind == 2) *(u32x4*)((bf16_t*)(ws + WS_V) + (size_t)row * QKW + cc) = w;
                    else *(u32x4*)((bf16_t*)(ws + WS_UX) + ((size_t)(cc >> 4) * NCH + (row >> 5)) * 768 + (row & 31) * 16 + (cc & 15)) = w;
                }
            }
    }
};

constexpr size_t WS_S    = WS_H;
constexpr size_t WS_MTAB = WS_H + 64 * MiB;
constexpr size_t TG_BYTES = (size_t)512 * 768 * 2, EST_OFF = TG_BYTES;
DEV void ssm_disc(const In& in, int dg, int n, float& abr, float& abi, float& fre, float& fim) {
    const int i = dg * NST + n; const float are = in.a_re[i], aim = in.a_im[i], dt = expf(in.log_step[dg]);
    const float decay = expf(are * dt); float sn, cs; sincosf(aim * dt, &sn, &cs);
    abr = decay * cs; abi = decay * sn; const float den = are * are + aim * aim, zr = abr - 1.0f;
    fre = (zr * are + abi * aim) / den; fim = (abi * are - zr * aim) / den;
}
DEV void p0_ssm_tables(Frame& F, const In& in) {
    unsigned char* ws = F.ws;
    const int tid = (F.vcu * NWAVES + F.wave) * 64 + F.lane, nthr = F.G * NWAVES * 64;
    float* Mtab = (float*)(ws + WS_MTAB);
    for (int t = tid; t < NG * 2 * 256; t += nthr) {
        const int q = t & 15, p = (t >> 4) & 15, dir = (t >> 8) & 1, g = t >> 9, dg = dir * NG + g;
        float M[32];
#pragma unroll
        for (int d = 0; d < 32; ++d) M[d] = 0.f;
        for (int n = 0; n < NST; ++n) {
            float abr, abi, fre, fim; ssm_disc(in, dg, n, abr, abi, fre, fim);
            const size_t bi = ((size_t)dg * NST + n) * GP + q, ci = ((size_t)dg * GP + p) * NST + n;
            const float br = in.b_re[bi], bim = in.b_im[bi], bbr = fre * br - fim * bim, bbi = fre * bim + fim * br;
            const float cr = in.c_re[ci], cim = in.c_im[ci];
            float zr = cr * bbr - cim * bbi, zi = cr * bbi + cim * bbr;
#pragma unroll
            for (int d = 0; d < 32; ++d) { M[d] += zr; const float nr = zr * abr - zi * abi, ni = zr * abi + zi * abr; zr = nr; zi = ni; }
        }
#pragma unroll
        for (int d = 0; d < 32; ++d) Mtab[(((size_t)g * 2 + dir) * 32 + d) * 256 + p * 16 + q] = M[d];
    }
    for (int t = tid; t < NG * 2 * NST * GP; t += nthr) {
        const int q = t & 15, n = (t >> 4) & 63, dir = (t >> 10) & 1, g = t >> 11, dg = dir * NG + g;
        float abr, abi, fre, fim; ssm_disc(in, dg, n, abr, abi, fre, fim);
        const size_t bi = ((size_t)dg * NST + n) * GP + q; const float br = in.b_re[bi], bim = in.b_im[bi];
        float zr = fre * br - fim * bim, zi = fre * bim + fim * br;
        bf16_t* Est = (bf16_t*)(ws + WS_TAB + (size_t)g * MiB + EST_OFF);
        for (int d = 0; d < TC; ++d) {
            const int j = dir ? d : TC - 1 - d;
            Est[(size_t)(dir * 128 + n) * 512 + j * 16 + q] = f2bf(zr); Est[(size_t)(dir * 128 + 64 + n) * 512 + j * 16 + q] = f2bf(zi);
            const float nr = zr * abr - zi * abi, ni = zr * abi + zi * abr; zr = nr; zi = ni;
        }
    }
    for (int t = tid; t < NG * 2 * GP * NST; t += nthr) {
        const int n = t & 63, p = (t >> 6) & 15, dir = (t >> 10) & 1, g = t >> 11, dg = dir * NG + g;
        float abr, abi, fre, fim; ssm_disc(in, dg, n, abr, abi, fre, fim);
        const size_t ci = ((size_t)dg * GP + p) * NST + n; const float cr = in.c_re[ci], cim = in.c_im[ci];
        float zr = cr * abr - cim * abi, zi = cr * abi + cim * abr;
        bf16_t* TG = (bf16_t*)(ws + WS_TAB + (size_t)g * MiB);
        for (int k = 1; k <= TC; ++k) {
            const int i = dir ? TC - k : k - 1;
            TG[(size_t)(i * 16 + p) * 768 + 512 + dir * 128 + n] = f2bf(zr); TG[(size_t)(i * 16 + p) * 768 + 512 + dir * 128 + 64 + n] = f2bf(-zi);
            const float nr = zr * abr - zi * abi, ni = zr * abi + zi * abr; zr = nr; zi = ni;
        }
    }
}
DEV void p4_scan(Frame& F, const In& in, int idx) {
    unsigned char* ws = F.ws;
    const int n = idx & 63, dir = (idx >> 6) & 1, g = idx >> 7, dg = dir * NG + g;
    float abr, abi, fre, fim; ssm_disc(in, dg, n, abr, abi, fre, fim);
    float xr = 0.f, xi = 0.f;
    if (dir == 0) {
        float br[GP], bi[GP];
#pragma unroll
        for (int q = 0; q < GP; ++q) { const size_t bx = ((size_t)dg * NST + n) * GP + q; const float b0 = in.b_re[bx], b1 = in.b_im[bx]; br[q] = fre * b0 - fim * b1; bi[q] = fre * b1 + fim * b0; }
        const float* um = (const float*)(ws + WS_CTL + C_UMETA);
        for (int j = 0; j < NMETA; ++j) { float bur = 0.f, bui = 0.f;
#pragma unroll
            for (int q = 0; q < GP; ++q) { const float u = um[(size_t)j * SSMW + g * GP + q]; bur += br[q] * u; bui += bi[q] * u; }
            const float nr = abr * xr - abi * xi + bur, ni = abr * xi + abi * xr + bui; xr = nr; xi = ni; }
    }
    float pr = abr, pi = abi;
#pragma unroll
    for (int k = 0; k < 5; ++k) { const float nr = pr * pr - pi * pi, ni = 2.0f * pr * pi; pr = nr; pi = ni; }
    const float* S = (const float*)(ws + WS_S) + (size_t)g * NCH * 256 + dir * 128 + n;
    bf16_t* X = (bf16_t*)(ws + WS_UX) + (size_t)g * NCH * 768 + 512 + dir * 128 + n;
    for (int c0 = 0; c0 < NCH; c0 += 8) {
        float sr[8], si[8];
#pragma unroll
        for (int k = 0; k < 8; ++k) { const int c = dir ? NCH - 1 - (c0 + k) : c0 + k; sr[k] = S[(size_t)c * 256]; si[k] = S[(size_t)c * 256 + 64]; }
#pragma unroll
        for (int k = 0; k < 8; ++k) { const int c = dir ? NCH - 1 - (c0 + k) : c0 + k;
            X[(size_t)c * 768] = f2bf(xr); X[(size_t)c * 768 + 64] = f2bf(xi);
            const float nr = pr * xr - pi * xi + sr[k], ni = pr * xi + pi * xr + si[k]; xr = nr; xi = ni; }
    }
}
DEV void p4_expand(Frame& F, const In& in, int worker, int nworkers) {
    unsigned char* ws = F.ws;
    const float* Mtab = (const float*)(ws + WS_MTAB);
    for (int it = worker; it < NG * 512 * 64; it += nworkers) {
        const int kc = it & 63, row = (it >> 6) & 511, g = it >> 15;
        const int j = kc >> 1, q0 = (kc & 1) * 8, i = row >> 4, p = row & 15;
        float v[8];
#pragma unroll
        for (int e = 0; e < 8; ++e) v[e] = 0.f;
        if (j <= i) { const float* m = Mtab + (((size_t)g * 2 + 0) * 32 + (i - j)) * 256 + p * 16 + q0;
#pragma unroll
            for (int e = 0; e < 8; ++e) v[e] += m[e]; }
        if (j >= i) { const float* m = Mtab + (((size_t)g * 2 + 1) * 32 + (j - i)) * 256 + p * 16 + q0;
#pragma unroll
            for (int e = 0; e < 8; ++e) v[e] += m[e]; }
        if (i == j) {
#pragma unroll
            for (int e = 0; e < 8; ++e) if (q0 + e == p) v[e] += in.ssm_d[g * GP + p]; }
        uint4 o; o.x = pk2(v[0], v[1]); o.y = pk2(v[2], v[3]); o.z = pk2(v[4], v[5]); o.w = pk2(v[6], v[7]);
        *(uint4*)((bf16_t*)(ws + WS_TAB + (size_t)g * MiB) + (size_t)row * 768 + j * 16 + q0) = o;
    }
}
struct SsmOrder {
    const char* A; const char* B; size_t bgstride, bnstride; int npm, npn, G, vcu;
    __device__ __forceinline__ bool next(int i, pg8::Unit& u) const {
        const int L = i * G + vcu; if (L >= NG * npm * npn) return false;
        const int pn = L % npn, pm = (L / npn) % npm, g = L / (npn * npm);
        u.pm = pm; u.pn = pn; u.e = g; u.slot0 = 0;
        u.A = A + ((size_t)g * NCH + (size_t)pm * 256) * 768 * 2; u.B = B + (size_t)g * bgstride + (size_t)pn * bnstride; return true;
    }
};
struct EpiSsmS {
    static constexpr int MIDK_T = 0;
    unsigned char* ws;
    __device__ __forceinline__ void midk(pg8::f32x4 (&)[2][2][4][2], const pg8::Unit&, int, int, int, int) const {}
    __device__ __forceinline__ void operator()(const pg8::f32x4 (&acc)[2][2][4][2], const pg8::Unit& u, int wr, int wc, int fr, int fq) const {
        using namespace pg8;
        float* S = (float*)(ws + WS_S) + (size_t)u.e * NCH * 256;
#pragma unroll
        for (int ai = 0; ai < 2; ++ai)
#pragma unroll
            for (int m = 0; m < 4; ++m) { const int c = u.pm * BM + ai * HALF + wr * 64 + m * 16 + fr;
#pragma unroll
                for (int bj = 0; bj < 2; ++bj) { float* o = S + (size_t)c * 256 + bj * HALF + wc * 32 + fq * 8; *(f32x4*)o = acc[ai][bj][m][0]; *(f32x4*)(o + 4) = acc[ai][bj][m][1]; } }
    }
};
struct EpiSsmY {
    static constexpr int MIDK_T = 0;
    unsigned char* ws;
    __device__ __forceinline__ void midk(pg8::f32x4 (&)[2][2][4][2], const pg8::Unit&, int, int, int, int) const {}
    __device__ __forceinline__ void operator()(const pg8::f32x4 (&acc)[2][2][4][2], const pg8::Unit& u, int wr, int wc, int fr, int fq) const {
        using namespace pg8;
        bf16_t* YS = (bf16_t*)(ws + WS_YS);
#pragma unroll
        for (int ai = 0; ai < 2; ++ai)
#pragma unroll
            for (int m = 0; m < 4; ++m) { const int c = u.pm * BM + ai * HALF + wr * 64 + m * 16 + fr;
#pragma unroll
                for (int bj = 0; bj < 2; ++bj) {
                    const int cc = u.pn * 256 + bj * HALF + wc * 32 + fq * 8, i = cc >> 4, p0 = cc & 15;
                    float y[8];
#pragma unroll
                    for (int n = 0; n < 2; ++n)
#pragma unroll
                        for (int jx = 0; jx < 4; ++jx) { const float x = acc[ai][bj][m][n][jx]; const float t2 = 2.0f * 0.7978845608028654f * (x + 0.044715f * x * x * x);
                            y[4 * n + jx] = x * __builtin_amdgcn_rcpf(1.0f + __builtin_amdgcn_exp2f(-t2 * LOG2E)); }
                    u32x4 w; w.x = cvt_pk_bf16(y[0], y[1]); w.y = cvt_pk_bf16(y[2], y[3]); w.z = cvt_pk_bf16(y[4], y[5]); w.w = cvt_pk_bf16(y[6], y[7]);
                    *(u32x4*)(YS + (size_t)(32 * c + i) * SSMW + u.e * GP + p0) = w;
                } }
    }
};

struct EpiGluF {
    static constexpr int MIDK_T = 0;
    unsigned char* ws; const float* bglu;
    __device__ __forceinline__ void midk(pg8::f32x4 (&)[2][2][4][2], const pg8::Unit&, int, int, int, int) const {}
    __device__ __forceinline__ void operator()(const pg8::f32x4 (&acc)[2][2][4][2], const pg8::Unit& u, int wr, int wc, int fr, int fq) const {
        using namespace pg8;
        const bf16_t* YS = (const bf16_t*)(ws + WS_YS); bf16_t* CAT = (bf16_t*)(ws + WS_CAT); float* SSQ = (float*)(ws + WS_SSQ);
        const int col0 = u.pn * 256 + wc * 32 + fq * 8;
        f32x4 bv[2][2];
#pragma unroll
        for (int bj = 0; bj < 2; ++bj)
#pragma unroll
            for (int n = 0; n < 2; ++n) bv[bj][n] = *(const f32x4*)(bglu + col0 + bj * HALF + 4 * n);
#pragma unroll
        for (int ai = 0; ai < 2; ++ai)
#pragma unroll
            for (int m = 0; m < 4; ++m) {
                const int row = u.pm * BM + ai * HALF + wr * 64 + m * 16 + fr; float ss = 0.f;
#pragma unroll
                for (int bj = 0; bj < 2; ++bj) {
                    const u32x4 yv = *(const u32x4*)(YS + (size_t)row * SSMW + col0 + bj * HALF);
                    const float y[8] = {__uint_as_float(yv.x << 16), __uint_as_float(yv.x & 0xffff0000u), __uint_as_float(yv.y << 16), __uint_as_float(yv.y & 0xffff0000u),
                                        __uint_as_float(yv.z << 16), __uint_as_float(yv.z & 0xffff0000u), __uint_as_float(yv.w << 16), __uint_as_float(yv.w & 0xffff0000u)};
                    float so[8];
#pragma unroll
                    for (int n = 0; n < 2; ++n)
#pragma unroll
                        for (int jx = 0; jx < 4; ++jx) { const float z = acc[ai][bj][m][n][jx] + bv[bj][n][jx]; so[4 * n + jx] = y[4 * n + jx] * __builtin_amdgcn_rcpf(1.0f + __builtin_amdgcn_exp2f(-z * LOG2E)); ss += so[4 * n + jx] * so[4 * n + jx]; }
                    u32x4 w; w.x = cvt_pk_bf16(so[0], so[1]); w.y = cvt_pk_bf16(so[2], so[3]); w.z = cvt_pk_bf16(so[4], so[5]); w.w = cvt_pk_bf16(so[6], so[7]);
                    *(u32x4*)(CAT + (size_t)row * DM + col0 + bj * HALF) = w;
                }
                ss += __shfl_xor(ss, 16); ss += __shfl_xor(ss, 32);
                if (fq == 0) SSQ[(size_t)row * 16 + u.pn * 4 + wc] = ss;
            }
    }
};
struct EpiOutF {
    static constexpr int MIDK_T = 16;
    unsigned char* ws; const float* x;
    __device__ __forceinline__ void midk(pg8::f32x4 (&acc)[2][2][4][2], const pg8::Unit& u, int wr, int wc, int fr, int fq) const {
        using namespace pg8;
        const float* SSQ = (const float*)(ws + WS_SSQ);
#pragma unroll
        for (int ai = 0; ai < 2; ++ai)
#pragma unroll
            for (int m = 0; m < 4; ++m) {
                const int row = u.pm * BM + ai * HALF + wr * 64 + m * 16 + fr;
                const f32x4 a = *(const f32x4*)(SSQ + (size_t)row * 16), b = *(const f32x4*)(SSQ + (size_t)row * 16 + 4), c = *(const f32x4*)(SSQ + (size_t)row * 16 + 8), d = *(const f32x4*)(SSQ + (size_t)row * 16 + 12);
                const float ss = (((a[0] + a[1]) + (a[2] + a[3])) + ((b[0] + b[1]) + (b[2] + b[3]))) + (((c[0] + c[1]) + (c[2] + c[3])) + ((d[0] + d[1]) + (d[2] + d[3])));
                const float rs = rsqrtf(ss * (1.0f / SSMW) + EPS);
#pragma unroll
                for (int bj = 0; bj < 2; ++bj)
#pragma unroll
                    for (int n = 0; n < 2; ++n) acc[ai][bj][m][n] = acc[ai][bj][m][n] * rs;
            }
    }
    __device__ __forceinline__ void operator()(const pg8::f32x4 (&acc)[2][2][4][2], const pg8::Unit& u, int wr, int wc, int fr, int fq) const {
        using namespace pg8;
        float* H = (float*)(ws + WS_H); bf16_t* HB = (bf16_t*)(ws + WS_HB);
        const int col0 = u.pn * 256 + wc * 32 + fq * 8;
#pragma unroll
        for (int ai = 0; ai < 2; ++ai)
#pragma unroll
            for (int m = 0; m < 4; ++m) {
                const int row = u.pm * BM + ai * HALF + wr * 64 + m * 16 + fr;
#pragma unroll
                for (int bj = 0; bj < 2; ++bj) {
                    const size_t o = (size_t)row * DM + col0 + bj * HALF;
                    const f32x4 v0 = acc[ai][bj][m][0] + *(const f32x4*)(x + o), v1 = acc[ai][bj][m][1] + *(const f32x4*)(x + o + 4);
                    *(f32x4*)(H + o) = v0; *(f32x4*)(H + o + 4) = v1;
                    u32x4 w; w.x = cvt_pk_bf16(v0[0], v0[1]); w.y = cvt_pk_bf16(v0[2], v0[3]); w.z = cvt_pk_bf16(v1[0], v1[1]); w.w = cvt_pk_bf16(v1[2], v1[3]);
                    *(u32x4*)(HB + o) = w;
                }
            }
    }
};
DEV void route_token(const In& in, unsigned char* ws, int t, int lane, float logit) {
    const float score = sigmoidf_(logit);
    const float choice = score + in.router_bias[lane];
    float m1 = choice;
#pragma unroll
    for (int o = 1; o < 8; o <<= 1) m1 = fmaxf(m1, __shfl_xor(m1, o));
    const unsigned long long b1 = __ballot(choice == m1); const int gbase = lane & ~7;
    const unsigned gb = (unsigned)((b1 >> gbase) & 0xffull); const int first = gbase + __builtin_ctz(gb | 0x100u);
    float m2 = (lane == first) ? -INFINITY : choice;
#pragma unroll
    for (int o = 1; o < 8; o <<= 1) m2 = fmaxf(m2, __shfl_xor(m2, o));
    const float gs = m1 + m2;
    int grank = 0; const int myg = lane >> 3;
#pragma unroll
    for (int j = 0; j < 8; ++j) { const float o = __shfl(gs, j * 8); grank += (o > gs || (o == gs && j < myg)) ? 1 : 0; }
    const float mv = grank < 4 ? choice : -INFINITY;
    int rank = 0;
    for (int j = 0; j < 64; ++j) { const float o = __shfl(mv, j); rank += (o > mv || (o == mv && j < lane)) ? 1 : 0; }
    const bool sel = rank < TOPK;
    const float ssum = wave_sum(sel ? score : 0.f);
    if (sel) {
        const int pos = atomicAdd((int*)(ws + WS_CTL + C_CNT) + lane, 1);
        ((int*)(ws + WS_CTL + C_IDX))[t * TOPK + rank] = lane;
        ((float*)(ws + WS_CTL + C_WTS))[t * TOPK + rank] = score / ssum * 2.5f;
        ((int*)(ws + WS_CTL + C_POS))[t * TOPK + rank] = pos;
    }
}
DEV void p8_router(Frame& F, const In& in) {
    unsigned char* ws = F.ws;
    typedef float f32x4v __attribute__((ext_vector_type(4)));
    const float* H = (const float*)(ws + WS_H); const float* WR = (const float*)(ws + WS_WR);
    LAS float* lg = (LAS float*)(F.lds + F.wave * 4096);
    const int gw = F.vcu * NWAVES + F.wave, NGW = F.G * NWAVES, lane = F.lane, ti = lane & 15, kq = lane >> 4;
    for (int mt = gw; mt < T / 16; mt += NGW) {
        const int t0 = mt * 16;
        f32x4v acc[4]; acc[0] = (f32x4v){0.f, 0.f, 0.f, 0.f}; acc[1] = acc[0]; acc[2] = acc[0]; acc[3] = acc[0];
        float ssq = 0.f;
        const float* hrow = H + (size_t)(t0 + ti) * DM + 4 * kq;
        const float* wcol = WR + (size_t)(4 * kq) * NE + ti;
#pragma unroll 2
        for (int g = 0; g < DM / 16; ++g) {
            const f32x4v hv = *(const f32x4v*)(hrow + 16 * g);
            ssq += (hv[0] * hv[0] + hv[1] * hv[1]) + (hv[2] * hv[2] + hv[3] * hv[3]);
            float b[4][4];
#pragma unroll
            for (int jx = 0; jx < 4; ++jx)
#pragma unroll
                for (int n = 0; n < 4; ++n) b[jx][n] = wcol[(size_t)(16 * g + jx) * NE + 16 * n];
#pragma unroll
            for (int jx = 0; jx < 4; ++jx)
#pragma unroll
                for (int n = 0; n < 4; ++n) acc[n] = __builtin_amdgcn_mfma_f32_16x16x4f32(hv[jx], b[jx][n], acc[n], 0, 0, 0);
        }
        ssq += __shfl_xor(ssq, 16); ssq += __shfl_xor(ssq, 32);
        const float rs = rsqrtf(ssq * (1.0f / DM) + EPS);
        if (kq == 0) ((float*)(ws + WS_CTL + C_RSTDH))[t0 + ti] = rs;
#pragma unroll
        for (int r = 0; r < 4; ++r) { const float rr = __shfl(rs, 4 * kq + r);
#pragma unroll
            for (int n = 0; n < 4; ++n) lg[(4 * kq + r) * 64 + 16 * n + ti] = acc[n][r] * rr; }
        asm volatile("s_waitcnt lgkmcnt(0)" ::: "memory");
        for (int r = 0; r < 16; ++r) route_token(in, ws, t0 + r, lane, lg[r * 64 + lane]);
        asm volatile("s_waitcnt lgkmcnt(0)" ::: "memory");
    }
}
DEV void p9_scatter(Frame& F) {
    unsigned char* ws = F.ws;
    LAS int* offl = (LAS int*)F.lds;
    if (F.tid == 0) { int a = 0; for (int e = 0; e < NE; ++e) { const int c = __hip_atomic_load((const int*)(ws + WS_CTL + C_CNT) + e, __ATOMIC_RELAXED, __HIP_MEMORY_SCOPE_AGENT); offl[e] = a; offl[128 + e] = c; a += (c + 255) & ~255; } offl[NE] = a; }
    __syncthreads();
    const int tid = F.vcu * NWAVES * 64 + F.tid, nthr = F.G * NWAVES * 64;
    int* stok = (int*)(ws + WS_CTL + C_STOK); int* sdst = (int*)(ws + WS_CTL + C_SDST); float* sw = (float*)(ws + WS_CTL + C_SW);
    if (tid <= NE) ((int*)(ws + WS_CTL + C_OFF))[tid] = offl[tid];
    for (int i = tid; i < NSLOT; i += nthr) {
        int lo = 0, hi = NE;
        while (hi - lo > 1) { const int mid = (lo + hi) >> 1; if (offl[mid] <= i) lo = mid; else hi = mid; }
        const bool real = (i < offl[NE]) && (i - offl[lo] < offl[128 + lo]);
        if (!real) { stok[i] = 0; sdst[i] = -1; sw[i] = 0.f; }
    }
    for (int i = tid; i < T; i += nthr) stok[NSLOT + i] = i;
    for (int i = tid; i < T * TOPK; i += nthr) {
        const int e = ((const int*)(ws + WS_CTL + C_IDX))[i]; const int slot = offl[e] + ((const int*)(ws + WS_CTL + C_POS))[i];
        stok[slot] = i >> 3; sdst[slot] = i; sw[slot] = ((const float*)(ws + WS_CTL + C_WTS))[i];
    }
}

struct MoeOrder {
    const int* cnt; const int* off; const char* A; const char* B; const char* Bsh; size_t bstride_e, bstride_pn, astride_row; int npn, ngrp, gsz, x, j, gather;
    int n0, n1, n2, n3, n4, n5, n6, n7, o0, o1, o2, o3, o4, o5, o6, o7;
    __device__ __forceinline__ static int ld_agent(const int* p) { return __builtin_amdgcn_readfirstlane(__hip_atomic_load(p, __ATOMIC_RELAXED, __HIP_MEMORY_SCOPE_AGENT)); }
    __device__ __forceinline__ void init(const int* cnt_, const int* off_, const void* A_, size_t astride_row_, const void* B_, size_t bstride_e_, const void* Bsh_, size_t bstride_pn_, int npn_, int G, int vcu, int gather_) {
        cnt = cnt_; off = off_; A = (const char*)A_; B = (const char*)B_; Bsh = (const char*)Bsh_; bstride_e = bstride_e_; bstride_pn = bstride_pn_; astride_row = astride_row_; npn = npn_; gather = gather_;
        ngrp = (G % 8 == 0) ? 8 : 1; gsz = G / ngrp; x = vcu / gsz; j = vcu % gsz;
        n0 = n1 = n2 = n3 = n4 = n5 = n6 = n7 = 0; o0 = o1 = o2 = o3 = o4 = o5 = o6 = o7 = 0;
        if (ngrp == 8) {
#define MO_LD(k) n##k = ((ld_agent(cnt + x + 8 * k) + 255) >> 8) * npn; o##k = ld_agent(off + x + 8 * k);
            MO_LD(0) MO_LD(1) MO_LD(2) MO_LD(3) MO_LD(4) MO_LD(5) MO_LD(6) MO_LD(7)
#undef MO_LD
        }
    }
    __device__ __forceinline__ void fill(pg8::Unit& u, int e, int L, int ofs) const {
        const int mt = L / npn, pn = L % npn; u.e = e; u.pm = mt; u.pn = pn; u.slot0 = ofs + mt * 256;
        u.A = gather ? A : A + (size_t)u.slot0 * astride_row; u.B = B + (size_t)e * bstride_e + (size_t)pn * bstride_pn;
    }
    __device__ __forceinline__ bool next(int i, pg8::Unit& u) const {
        int L = i * gsz + j;
        if (ngrp == 8) {
#define MO_TRY(k) if (L < n##k) { fill(u, x + 8 * k, L, o##k); return true; } L -= n##k;
            MO_TRY(0) MO_TRY(1) MO_TRY(2) MO_TRY(3) MO_TRY(4) MO_TRY(5) MO_TRY(6) MO_TRY(7)
#undef MO_TRY
        } else {
            for (int e = 0; e < NE; ++e) { const int nu = ((ld_agent(cnt + e) + 255) >> 8) * npn; if (L < nu) { fill(u, e, L, ld_agent(off + e)); return true; } L -= nu; }
        }
        if (Bsh) {
            const int mtg = (T / 256) / ngrp, nu = mtg * npn;
            if (L < nu) { const int mt = x * mtg + L / npn, pn = L % npn; u.e = NE; u.pm = mt; u.pn = pn; u.slot0 = NSLOT + mt * 256; u.A = A; u.B = Bsh + (size_t)pn * bstride_pn; return true; }
        }
        return false;
    }
};
struct EpiGateUpF {
    static constexpr int MIDK_T = 0;
    unsigned char* ws;
    __device__ __forceinline__ void midk(pg8::f32x4 (&)[2][2][4][2], const pg8::Unit&, int, int, int, int) const {}
    __device__ __forceinline__ void operator()(const pg8::f32x4 (&acc)[2][2][4][2], const pg8::Unit& u, int wr, int wc, int fr, int fq) const {
        using namespace pg8;
        const int* stok = (const int*)(ws + WS_CTL + C_STOK); const float* rstd = (const float*)(ws + WS_CTL + C_RSTDH);
        const bool sh = u.e == NE;
        bf16_t* O = sh ? (bf16_t*)(ws + WS_HS) : (bf16_t*)(ws + WS_H1);
        const int col = u.pn * 128 + wc * 32 + fq * 8;
#pragma unroll
        for (int ai = 0; ai < 2; ++ai)
#pragma unroll
            for (int m = 0; m < 4; ++m) {
                const int slot = u.slot0 + ai * HALF + wr * 64 + m * 16 + fr;
                const int tok = stok[slot]; const float rs = rstd[tok];
                const size_t orow = sh ? (size_t)tok : (size_t)slot;
                float hh[8];
#pragma unroll
                for (int n = 0; n < 2; ++n)
#pragma unroll
                    for (int jx = 0; jx < 4; ++jx) { const float g = acc[ai][0][m][n][jx] * rs, up = acc[ai][1][m][n][jx] * rs; hh[4 * n + jx] = g * up * __builtin_amdgcn_rcpf(1.0f + __builtin_amdgcn_exp2f(-g * LOG2E)); }
                u32x4 w; w.x = cvt_pk_bf16(hh[0], hh[1]); w.y = cvt_pk_bf16(hh[2], hh[3]); w.z = cvt_pk_bf16(hh[4], hh[5]); w.w = cvt_pk_bf16(hh[6], hh[7]);
                *(u32x4*)(O + orow * EH + col) = w;
            }
    }
};
struct EpiDownF {
    static constexpr int MIDK_T = 0;
    unsigned char* ws;
    __device__ __forceinline__ void midk(pg8::f32x4 (&)[2][2][4][2], const pg8::Unit&, int, int, int, int) const {}
    __device__ __forceinline__ void operator()(const pg8::f32x4 (&acc)[2][2][4][2], const pg8::Unit& u, int wr, int wc, int fr, int fq) const {
        using namespace pg8;
        const int* sdst = (const int*)(ws + WS_CTL + C_SDST); const float* sw = (const float*)(ws + WS_CTL + C_SW);
        bf16_t* Y = (bf16_t*)(ws + WS_Y); const int col = u.pn * 256 + wc * 32 + fq * 8;
#pragma unroll
        for (int ai = 0; ai < 2; ++ai)
#pragma unroll
            for (int m = 0; m < 4; ++m) {
                const int slot = u.slot0 + ai * HALF + wr * 64 + m * 16 + fr;
                const int dst = sdst[slot]; const float w = sw[slot];
                if (dst >= 0) {
#pragma unroll
                    for (int bj = 0; bj < 2; ++bj) { const f32x4 v0 = acc[ai][bj][m][0] * w, v1 = acc[ai][bj][m][1] * w;
                        u32x4 o; o.x = cvt_pk_bf16(v0[0], v0[1]); o.y = cvt_pk_bf16(v0[2], v0[3]); o.z = cvt_pk_bf16(v1[0], v1[1]); o.w = cvt_pk_bf16(v1[2], v1[3]);
                        *(u32x4*)(Y + (size_t)dst * DM + col + bj * HALF) = o; }
                }
            }
    }
};
struct EpiFinalF {
    static constexpr int MIDK_T = 0;
    unsigned char* ws; float* out;
    __device__ __forceinline__ void midk(pg8::f32x4 (&)[2][2][4][2], const pg8::Unit&, int, int, int, int) const {}
    __device__ __forceinline__ void operator()(const pg8::f32x4 (&acc)[2][2][4][2], const pg8::Unit& u, int wr, int wc, int fr, int fq) const {
        using namespace pg8;
        const float* H = (const float*)(ws + WS_H); const bf16_t* Y = (const bf16_t*)(ws + WS_Y);
        const int col0 = u.pn * 256 + wc * 32 + fq * 8;
#pragma unroll
        for (int ai = 0; ai < 2; ++ai)
#pragma unroll
            for (int m = 0; m < 4; ++m) {
                const int row = u.pm * BM + ai * HALF + wr * 64 + m * 16 + fr;
#pragma unroll
                for (int bj = 0; bj < 2; ++bj) {
                    const int col = col0 + bj * HALF;
                    const f32x4 h0 = *(const f32x4*)(H + (size_t)row * DM + col), h1 = *(const f32x4*)(H + (size_t)row * DM + col + 4);
                    u32x4 y[TOPK];
#pragma unroll
                    for (int k = 0; k < TOPK; ++k) y[k] = *(const u32x4*)(Y + ((size_t)row * TOPK + k) * DM + col);
                    f32x4 v0 = acc[ai][bj][m][0] + h0, v1 = acc[ai][bj][m][1] + h1;
#pragma unroll
                    for (int k = 0; k < TOPK; ++k) {
                        v0[0] += __uint_as_float(y[k].x << 16); v0[1] += __uint_as_float(y[k].x & 0xffff0000u); v0[2] += __uint_as_float(y[k].y << 16); v0[3] += __uint_as_float(y[k].y & 0xffff0000u);
                        v1[0] += __uint_as_float(y[k].z << 16); v1[1] += __uint_as_float(y[k].z & 0xffff0000u); v1[2] += __uint_as_float(y[k].w << 16); v1[3] += __uint_as_float(y[k].w & 0xffff0000u); }
                    *(f32x4*)(out + (size_t)row * DM + col) = v0; *(f32x4*)(out + (size_t)row * DM + col + 4) = v1;
                }
            }
    }
};

struct Args { In in; float* out; unsigned char* ws; int ph_lo, ph_hi; };
typedef const __attribute__((address_space(4))) Args* KArgs;
#define PHASE_KA() KArgs ka = (KArgs)__builtin_amdgcn_kernarg_segment_ptr(); asm volatile("" : "+s"(ka)); unsigned char* ws = ka->ws; F.ws = ws
__global__ void __launch_bounds__(NWAVES * 64, 2) mk_fwd(Args args) {
    extern __shared__ __attribute__((aligned(16))) unsigned char lds[];
    Frame F; F.lds = (LAS unsigned char*)lds; F.tid = threadIdx.x; F.lane = F.tid & 63; F.wave = __builtin_amdgcn_readfirstlane(F.tid >> 6);
    F.G = gridDim.x; { const int bx = blockIdx.x; F.vcu = (F.G % 8 == 0) ? (bx % 8) * (F.G / 8) + bx / 8 : bx; }
    F.ws = args.ws;
    volatile LAS unsigned* MISC = (volatile LAS unsigned*)(F.lds + MISC_OFF);
    for (int u = F.tid; u < (LDS_BYTES - LDSCTL_OFF) / 4; u += NWAVES * 64) ((LAS unsigned*)(F.lds + LDSCTL_OFF))[u] = 0u;
    __syncthreads();
    XcdBarrier bar = xcd_barrier_post((unsigned*)(args.ws + WS_CTL + C_BAR), MISC + 8);
    const int lo = args.ph_lo, hi = args.ph_hi;
#define IN(k) (lo <= (k) && (k) < hi)
#define BOTH(k) (IN(k) && IN((k) + 1))
    if (IN(0)) { PHASE_KA(); const In in = *(const In*)&ka->in; p0_prologue(F, in); p0_ssm_tables(F, in); if (BOTH(0)) xcd_barrier(bar); }
    if (IN(1)) {
        PHASE_KA();
        pg8::DenseOrder S; S.init(ws + WS_XB, (size_t)256 * DM * 2, ws + WS_WT_IN, (size_t)256 * DM * 2, T / 256, INW / 256, F.G, (int)blockIdx.x);
        EpiInProjF E{ws, ka->in.q_norm, ka->in.k_norm};
        pg8::gemm_phase<EpiInProjF, pg8::DenseOrder, false, true>(F.lds, DM, DM, DM, S, E, nullptr);
        if (BOTH(1)) xcd_barrier(bar);
    }
    if (IN(2)) {
        PHASE_KA();
        const float lam = *(const float*)(ws + WS_CTL + C_LAM); const float* subln = ka->in.subln;
        LAS float* lutl = (LAS float*)(F.lds + att::LDS_LUT);
        for (int u = F.vcu; u < NH * (T / 128); u += F.G) {
            const int h = (u >> 5) & 7, qb = (u & 31) + 32 * (u >> 8);
            const float* lutg = (const float*)(ws + WS_CTL + C_LUT) + h * LUTN;
            const float ca = lutg[LUTN - 1], cb = lutg[0];
            for (int i = F.tid; i < LUTN; i += NWAVES * 64) lutl[i] = lutg[i] - ca;
            __syncthreads();
            att::attn_unit(h, qb, (const bf16_t*)(ws + WS_Q), (const bf16_t*)(ws + WS_K), (const bf16_t*)(ws + WS_V), (bf16_t*)(ws + WS_CAT), (char*)lds, lam, subln, exp2f(cb - ca));
        }
        if (BOTH(2)) xcd_barrier(bar);
    }
    if (IN(3)) {
        PHASE_KA();
        SsmOrder S{(const char*)(ws + WS_UX), (const char*)(ws + WS_TAB + EST_OFF), (size_t)MiB, 0, 2, 1, F.G, F.vcu};
        EpiSsmS E{ws};
        pg8::gemm_phase<EpiSsmS, SsmOrder, false, true>(F.lds, 768, 512, 512, S, E, nullptr);
        if (BOTH(3)) xcd_barrier(bar);
    }
    if (IN(4)) {
        PHASE_KA(); const In in = *(const In*)&ka->in;
        const int nscan = (NG * 2 * NST) / (NWAVES * 64);
        if (F.G > nscan) { if (F.vcu < nscan) p4_scan(F, in, F.vcu * NWAVES * 64 + F.tid); else p4_expand(F, in, (F.vcu - nscan) * NWAVES * 64 + F.tid, (F.G - nscan) * NWAVES * 64); }
        else { for (int idx = F.vcu * NWAVES * 64 + F.tid; idx < NG * 2 * NST; idx += F.G * NWAVES * 64) p4_scan(F, in, idx); p4_expand(F, in, F.vcu * NWAVES * 64 + F.tid, F.G * NWAVES * 64); }
        if (BOTH(4)) xcd_barrier(bar);
    }
    if (IN(5)) {
        PHASE_KA();
        SsmOrder S{(const char*)(ws + WS_UX), (const char*)(ws + WS_TAB), (size_t)MiB, (size_t)256 * 768 * 2, 2, 2, F.G, F.vcu};
        EpiSsmY E{ws};
        pg8::gemm_phase<EpiSsmY, SsmOrder, false, true>(F.lds, 768, 768, 768, S, E, nullptr);
        if (BOTH(5)) xcd_barrier(bar);
    }
    if (IN(6)) {
        PHASE_KA();
        pg8::DenseOrder S; S.init(ws + WS_YS, (size_t)256 * SSMW * 2, ws + WS_WT_GLU, (size_t)256 * SSMW * 2, T / 256, SSMW / 256, F.G, (int)blockIdx.x);
        EpiGluF E{ws, ka->in.b_glu};
        pg8::gemm_phase<EpiGluF, pg8::DenseOrder, false, true>(F.lds, SSMW, SSMW, SSMW, S, E, nullptr);
        if (BOTH(6)) xcd_barrier(bar);
    }
    if (IN(7)) {
        PHASE_KA();
        pg8::DenseOrder S; S.init(ws + WS_CAT, (size_t)256 * DM * 2, ws + WS_WT_OUT, (size_t)256 * DM * 2, T / 256, DM / 256, F.G, (int)blockIdx.x);
        EpiOutF E{ws, ka->in.x};
        pg8::gemm_phase<EpiOutF, pg8::DenseOrder, false, true>(F.lds, DM, DM, DM, S, E, nullptr);
        if (BOTH(7)) xcd_barrier(bar);
    }
    if (IN(8)) { PHASE_KA(); const In in = *(const In*)&ka->in; p8_router(F, in); if (BOTH(8)) xcd_barrier(bar); }
    if (IN(9)) { PHASE_KA(); p9_scatter(F); if (BOTH(9)) xcd_barrier(bar); }
    if (IN(10)) {
        PHASE_KA();
        MoeOrder S; S.init((const int*)(ws + WS_CTL + C_CNT), (const int*)(ws + WS_CTL + C_OFF), ws + WS_HB, 0, ws + WS_WGU, (size_t)1024 * DM * 2, ws + WS_WT_SHGU, (size_t)256 * DM * 2, 4, F.G, F.vcu, 1);
        EpiGateUpF E{ws};
        pg8::gemm_phase<EpiGateUpF, MoeOrder, true, true>(F.lds, DM, DM, DM, S, E, (const int*)(ws + WS_CTL + C_STOK));
        if (BOTH(10)) xcd_barrier(bar);
    }
    if (IN(11)) {
        PHASE_KA();
        MoeOrder S; S.init((const int*)(ws + WS_CTL + C_CNT), (const int*)(ws + WS_CTL + C_OFF), ws + WS_H1, (size_t)EH * 2, ws + WS_WDN, (size_t)DM * EH * 2, nullptr, (size_t)256 * EH * 2, 8, F.G, F.vcu, 0);
        EpiDownF E{ws};
        pg8::gemm_phase<EpiDownF, MoeOrder, false, true>(F.lds, EH, EH, EH, S, E, nullptr);
        if (BOTH(11)) xcd_barrier(bar);
    }
    if (IN(12)) {
        PHASE_KA();
        pg8::DenseOrder S; S.init(ws + WS_HS, (size_t)256 * SH * 2, ws + WS_WT_SHD, (size_t)256 * SH * 2, T / 256, DM / 256, F.G, (int)blockIdx.x);
        EpiFinalF E{ws, ka->out};
        pg8::gemm_phase<EpiFinalF, pg8::DenseOrder, false, true>(F.lds, SH, SH, SH, S, E, nullptr);
    }
#undef IN
#undef BOTH
}

extern "C" void kernel_launch(void* const* d_in, const int* in_sizes, int n_in, void* d_out, int out_size, void* d_ws, size_t ws_size, hipStream_t stream) {
    if (n_in != 33 || ws_size < WS_END) return;
    In in; { const float** p = (const float**)&in; for (int i = 0; i < 33; ++i) p[i] = (const float*)d_in[i]; }
    unsigned char* ws = (unsigned char*)d_ws; float* out = (float*)d_out;
    const int* cnt = (const int*)(ws + WS_CTL + C_CNT); const int* off = (const int*)(ws + WS_CTL + C_OFF);
    static int grid = 0;
    if (grid == 0) {
        int dev = 0, cus = 0;
        if (hipGetDevice(&dev) != hipSuccess || hipDeviceGetAttribute(&cus, hipDeviceAttributeMultiprocessorCount, dev) != hipSuccess) { grid = -1; return; }
        if (hipFuncSetAttribute((const void*)mk_fwd, hipFuncAttributeMaxDynamicSharedMemorySize, LDS_BYTES) != hipSuccess) { grid = -1; return; }
        grid = cus;
    }
    if (grid < 0) return;
    hipMemsetAsync(ws + WS_CTL, 0, C_ZERO_BYTES, stream);
    { Args a{}; a.in = in; a.out = out; a.ws = ws; a.ph_lo = 0; a.ph_hi = 13; hipLaunchKernelGGL(mk_fwd, dim3(grid), dim3(NWAVES * 64), LDS_BYTES, stream, a); }
}
```

```cpp
#include <hip/hip_runtime.h>
#include <stdint.h>
#include <math.h>

typedef unsigned short bf16_t;
#define DEV __device__ __forceinline__

constexpr int T = 16384, NMETA = 16, LTOT = T + NMETA, DM = 2048;
constexpr int NH = 8, HD = 64, DV = 128, QKW = 1024, INW = 4096;
constexpr int NG = 64, GP = 16, NST = 64, SSMW = 1024;
constexpr int TC = 32, NCH = T / TC;
constexpr int NE = 64, TOPK = 8, EH = 512, SH = 512;
constexpr int KROWS = 16448;
constexpr int NSLOT = T * TOPK + NE * 256;
constexpr float EPS = 1e-6f;
constexpr float LOG2E = 1.4426950408889634f;
constexpr float C2 = 0.125f * LOG2E;
constexpr int LUTN = 183;

constexpr size_t MiB = 1u << 20;
constexpr size_t WS_CTL   = 0;
constexpr size_t WS_WSM   = 8 * MiB;
constexpr size_t WS_WDN   = 40 * MiB;
constexpr size_t WS_H     = 168 * MiB;
constexpr size_t WS_HS    = 296 * MiB;
constexpr size_t WS_H1    = 312 * MiB;
constexpr size_t WS_Y     = 456 * MiB;
constexpr size_t WS_WGU   = 456 * MiB;
constexpr size_t WS_HB    = 712 * MiB;
constexpr size_t WS_CAT   = 776 * MiB;
constexpr size_t WS_TAB   = 840 * MiB;
constexpr size_t WS_XB    = 904 * MiB;
constexpr size_t WS_UX    = 969 * MiB;
constexpr size_t WS_Q     = WS_H1;
constexpr size_t WS_K     = WS_H1 + 32 * MiB;
constexpr size_t WS_V     = WS_H1 + 65 * MiB;
constexpr size_t WS_OACC  = WS_H;
constexpr size_t WS_YF    = WS_H1;
constexpr size_t WS_YR    = WS_H1 + 64 * MiB;
constexpr size_t WS_YS    = WS_H + 32 * MiB;
constexpr size_t WS_TMP   = WS_H1;
constexpr size_t WS_END   = 1017 * MiB;

constexpr size_t C_BAR     = 0;
constexpr size_t C_CNT     = 13824;
constexpr size_t C_ZERO_BYTES = 16384;
constexpr size_t C_OFF     = 16384;
constexpr size_t C_LAM     = 17408;
constexpr size_t C_LUT     = 20480;
constexpr size_t C_RSTDX   = 32768;
constexpr size_t C_RSTDS   = C_RSTDX + 16640 * 4;
constexpr size_t C_RSTDH   = C_RSTDS + 16384 * 4;
constexpr size_t C_UMETA   = C_RSTDH + 16384 * 4;
constexpr size_t C_SSMP    = 512 * 1024;
constexpr size_t WS_LOGIT  = WS_XB;
constexpr size_t C_IDX     = 2 * MiB;
constexpr size_t C_WTS     = C_IDX + 512 * 1024;
constexpr size_t C_POS     = C_WTS + 512 * 1024;
constexpr size_t C_STOK    = C_POS + 512 * 1024;
constexpr size_t C_SDST    = C_STOK + 640 * 1024;
constexpr size_t C_SW      = C_SDST + 640 * 1024;
static_assert(C_SW + NSLOT * 4 <= 8 * MiB, "ctl map");
static_assert(C_SSMP + (2 * 64 * 64 * 2 + 2 * 64 * 64 * 16 * 2) * 4 <= C_IDX, "ctl map");
static_assert(C_UMETA + 16 * 1024 * 4 <= C_SSMP, "ctl map");
constexpr size_t WS_SSQ   = 6 * MiB;
constexpr size_t WS_WR    = 7 * MiB;
static_assert(C_SW + NSLOT * 4 + T * 4 <= WS_SSQ, "ctl map");
constexpr size_t WS_WT_IN   = WS_WSM;
constexpr size_t WS_WT_OUT  = WS_WSM + 16 * MiB;
constexpr size_t WS_WT_SHGU = WS_WSM + 24 * MiB;
constexpr size_t WS_WT_SHD  = WS_WSM + 28 * MiB;
constexpr size_t WS_WT_GLU  = WS_WSM + 30 * MiB;

DEV float bf2f(bf16_t b) { return __uint_as_float(((unsigned)b) << 16); }
DEV bf16_t f2bf(float f) { unsigned u = __float_as_uint(f); return (bf16_t)((u + 0x7fffu + ((u >> 16) & 1u)) >> 16); }
DEV float wave_sum(float v) {
#pragma unroll
    for (int o = 1; o < 64; o <<= 1) v += __shfl_xor(v, o);
    return v;
}
DEV float sigmoidf_(float x) { return 1.0f / (1.0f + __expf(-x)); }
DEV float gelu_tanh(float x) { const float u = 0.7978845608028654f * (x + 0.044715f * x * x * x); return 0.5f * x * (1.0f + tanhf(u)); }

struct In {
    const float *x, *meta, *rel_bias, *norm_mix, *w_in, *q_norm, *k_norm, *lam_q1, *lam_k1, *lam_q2, *lam_k2, *subln;
    const float *a_re, *a_im, *log_step, *b_re, *b_im, *c_re, *c_im, *ssm_d, *w_glu, *b_glu, *ssm_norm, *w_out, *norm_ffn;
    const float *router_w, *router_bias, *w_gate, *w_up, *w_down, *sh_gate, *sh_up, *sh_down;
};

__global__ void __launch_bounds__(256) k_prep_x(In in, unsigned char* ws) {
    const int wave = (blockIdx.x * 256 + threadIdx.x) >> 6, lane = threadIdx.x & 63;
    if (wave >= LTOT) return;
    const float* src = wave < T ? in.x + (size_t)wave * DM : in.meta + (size_t)(wave - T) * DM;
    bf16_t* dst = (bf16_t*)(ws + WS_XB) + (size_t)wave * DM;
    float ss = 0.f;
    for (int j = 0; j < DM / 256; ++j) {
        const float4 v = *(const float4*)(src + j * 256 + lane * 4);
        ss += v.x * v.x + v.y * v.y + v.z * v.z + v.w * v.w;
        ushort4 o; o.x = f2bf(v.x); o.y = f2bf(v.y); o.z = f2bf(v.z); o.w = f2bf(v.w);
        *(ushort4*)(dst + j * 256 + lane * 4) = o;
    }
    ss = wave_sum(ss);
    if (lane == 0) ((float*)(ws + WS_CTL + C_RSTDX))[wave] = rsqrtf(ss * (1.0f / DM) + EPS);
}

DEV int t5_bucket(int rel) {
    const int n = rel < 0 ? -rel : rel;
    int b;
    if (n < 8) b = n;
    else { const float nf = (float)n; int large = 8 + (int)(logf(nf / 8.0f) / 2.772588722239781f * 8.0f); b = large < 15 ? large : 15; }
    return (rel > 0 ? 16 : 0) + b;
}
__global__ void __launch_bounds__(256) k_tables(In in, unsigned char* ws) {
    const int tid = blockIdx.x * 256 + threadIdx.x, nthr = gridDim.x * 256;
    float* lut = (float*)(ws + WS_CTL + C_LUT);
    for (int i = tid; i < NH * LUTN; i += nthr) { const int h = i / LUTN, rel = i % LUTN - 91; lut[i] = in.rel_bias[t5_bucket(rel) * NH + h] * LOG2E; }
    if (tid == 0) {
        float s1 = 0.f, s2 = 0.f;
        for (int i = 0; i < HD; ++i) { s1 += in.lam_q1[i] * in.lam_k1[i]; s2 += in.lam_q2[i] * in.lam_k2[i]; }
        *(float*)(ws + WS_CTL + C_LAM) = expf(s1) - expf(s2) + 0.2f;
    }
    float* abar = (float*)(ws + WS_CTL + C_SSMP);
    float* bbar = abar + 2 * 64 * 64 * 2;
    for (int i = tid; i < 2 * NG * NST; i += nthr) {
        const int dg = i / NST;
        const float are = in.a_re[i], aim = in.a_im[i], dt = expf(in.log_step[dg]);
        const float decay = expf(are * dt); float sn, cs; sincosf(aim * dt, &sn, &cs);
        const float abr = decay * cs, abi = decay * sn, den = are * are + aim * aim, zr = abr - 1.0f;
        const float fre = (zr * are + abi * aim) / den, fim = (abi * are - zr * aim) / den;
        abar[i * 2] = abr; abar[i * 2 + 1] = abi;
        for (int p = 0; p < GP; ++p) { const float br = in.b_re[(size_t)i * GP + p], bi = in.b_im[(size_t)i * GP + p];
            bbar[((size_t)i * GP + p) * 2] = fre * br - fim * bi; bbar[((size_t)i * GP + p) * 2 + 1] = fre * bi + fim * br; }
    }
    bf16_t* Kb = (bf16_t*)(ws + WS_K); bf16_t* Vb = (bf16_t*)(ws + WS_V);
    for (int i = tid; i < (KROWS - LTOT) * QKW; i += nthr) { Kb[(size_t)LTOT * QKW + i] = 0; Vb[(size_t)LTOT * QKW + i] = 0; }
}

struct NG_ {
    const void* A; const int* rows; const float* kgain; const float* B; const float* B2; const int* goff; const int* gcnt; size_t bstride;
    int lda, ldb, M, N, K, pad;
};
static NG_ mk(const void* A, int lda, const int* rows, const float* kgain, const float* B, int ldb, const float* B2, size_t bstride, int M, int N, int K, const int* goff, const int* gcnt) {
    NG_ g{}; g.A = A; g.rows = rows; g.kgain = kgain; g.B = B; g.B2 = B2; g.goff = goff; g.gcnt = gcnt; g.bstride = bstride; g.lda = lda; g.ldb = ldb; g.M = M; g.N = N; g.K = K; g.pad = 0; return g;
}
template <class Epi, bool A_BF16, bool DUAL>
__global__ void __launch_bounds__(256) k_ngemm(NG_ g, Epi E) {
    __shared__ float As[16][68];
    __shared__ float Bs[16][68];
    __shared__ float Bs2[DUAL ? 16 : 1][68];
    __shared__ float Ct[64][65];
    __shared__ float Ct2[DUAL ? 64 : 1][65];
    const int tid = threadIdx.x, e = blockIdx.z;
    int M = g.M, rowbase = 0;
    if (g.goff) { M = g.gcnt[e]; rowbase = g.goff[e]; }
    const int m0 = blockIdx.y * 64, n0 = blockIdx.x * 64;
    if (m0 >= M) return;
    const float* B = g.B + (size_t)e * g.bstride; const float* B2 = DUAL ? g.B2 + (size_t)e * g.bstride : nullptr;
    const int ar = tid >> 2, akq = (tid & 3) * 4;
    const int bk = tid >> 4, bn = (tid & 15) * 4;
    const int ty = tid >> 4, tx = tid & 15;
    const bool arow_ok = (m0 + ar) < M;
    long asrc = 0;
    if (arow_ok) { const int r = rowbase + m0 + ar; asrc = g.rows ? (long)g.rows[r] : (long)r; }
    float acc[4][4] = {}, acc2[4][4] = {};
    for (int k0 = 0; k0 < g.K; k0 += 16) {
        float a4[4] = {0.f, 0.f, 0.f, 0.f};
        if (arow_ok) {
            if (A_BF16) { const ushort4 v = *(const ushort4*)((const bf16_t*)g.A + asrc * g.lda + k0 + akq); a4[0] = bf2f(v.x); a4[1] = bf2f(v.y); a4[2] = bf2f(v.z); a4[3] = bf2f(v.w); }
            else { const float4 v = *(const float4*)((const float*)g.A + asrc * g.lda + k0 + akq); a4[0] = v.x; a4[1] = v.y; a4[2] = v.z; a4[3] = v.w; }
            if (g.kgain) { const float4 kg = *(const float4*)(g.kgain + k0 + akq); a4[0] *= kg.x; a4[1] *= kg.y; a4[2] *= kg.z; a4[3] *= kg.w; }
        }
#pragma unroll
        for (int i = 0; i < 4; ++i) As[akq + i][ar] = a4[i];
        { const float4 v = *(const float4*)(B + (size_t)(k0 + bk) * g.ldb + n0 + bn); Bs[bk][bn] = v.x; Bs[bk][bn + 1] = v.y; Bs[bk][bn + 2] = v.z; Bs[bk][bn + 3] = v.w; }
        if (DUAL) { const float4 v = *(const float4*)(B2 + (size_t)(k0 + bk) * g.ldb + n0 + bn); Bs2[bk][bn] = v.x; Bs2[bk][bn + 1] = v.y; Bs2[bk][bn + 2] = v.z; Bs2[bk][bn + 3] = v.w; }
        __syncthreads();
#pragma unroll
        for (int k = 0; k < 16; ++k) {
            float a[4], b[4], b2[4];
#pragma unroll
            for (int i = 0; i < 4; ++i) { a[i] = As[k][ty * 4 + i]; b[i] = Bs[k][tx * 4 + i]; if (DUAL) b2[i] = Bs2[k][tx * 4 + i]; }
#pragma unroll
            for (int i = 0; i < 4; ++i)
#pragma unroll
                for (int j = 0; j < 4; ++j) { acc[i][j] += a[i] * b[j]; if (DUAL) acc2[i][j] += a[i] * b2[j]; }
        }
        __syncthreads();
    }
#pragma unroll
    for (int i = 0; i < 4; ++i)
#pragma unroll
        for (int j = 0; j < 4; ++j) { Ct[ty * 4 + i][tx * 4 + j] = acc[i][j]; if (DUAL) Ct2[ty * 4 + i][tx * 4 + j] = acc2[i][j]; }
    __syncthreads();
    const int rr = tid >> 2, cq = (tid & 3) * 16;
    E.tile(&Ct[rr][cq], DUAL ? &Ct2[rr][cq] : nullptr, rowbase + m0 + rr, (m0 + rr) < M, n0 + cq, n0, e);
}

struct EpiInProj {
    unsigned char* ws; const float* qn; const float* kn;
    DEV void tile(const float* c, const float*, int row, bool ok, int col, int n0, int) const {
        const float rs = ((const float*)(ws + WS_CTL + C_RSTDX))[ok ? row : 0];
        float v[16]; float ss = 0.f;
#pragma unroll
        for (int i = 0; i < 16; ++i) { v[i] = c[i] * rs; ss += v[i] * v[i]; }
        ss += __shfl_xor(ss, 1); ss += __shfl_xor(ss, 2);
        if (!ok) return;
        if (n0 < 2 * QKW) {
            const float r = rsqrtf(ss * (1.0f / 64.0f) + EPS);
            const bool isq = n0 < QKW; const int cc = isq ? col : col - QKW; const int d0 = cc & 63;
            if (isq) { if (row < T) { bf16_t* o = (bf16_t*)(ws + WS_Q) + (size_t)row * QKW + cc;
#pragma unroll
                for (int i = 0; i < 16; ++i) o[i] = f2bf(v[i] * r * qn[d0 + i] * C2); } }
            else { bf16_t* o = (bf16_t*)(ws + WS_K) + (size_t)row * QKW + cc;
#pragma unroll
                for (int i = 0; i < 16; ++i) o[i] = f2bf(v[i] * r * kn[d0 + i]); }
        } else if (n0 < 3 * QKW) {
            bf16_t* o = (bf16_t*)(ws + WS_V) + (size_t)row * QKW + (col - 2 * QKW);
#pragma unroll
            for (int i = 0; i < 16; ++i) o[i] = f2bf(v[i]);
        } else {
            const int cu = col - 3 * QKW, gidx = cu >> 4;
            if (row < T) { bf16_t* o = (bf16_t*)(ws + WS_UX) + ((size_t)gidx * NCH + (row >> 5)) * 768 + (row & 31) * 16;
#pragma unroll
                for (int i = 0; i < 16; ++i) o[i] = f2bf(v[i]); }
            else { float* o = (float*)(ws + WS_CTL + C_UMETA) + (size_t)(row - T) * SSMW + cu;
#pragma unroll
                for (int i = 0; i < 16; ++i) o[i] = v[i]; }
        }
    }
};
struct EpiGlu {
    unsigned char* ws; const float* bglu;
    DEV void tile(const float* c, const float*, int row, bool ok, int col, int, int) const {
        if (!ok) return;
        const bf16_t* ys = (const bf16_t*)(ws + WS_YS) + (size_t)row * SSMW + col; bf16_t* o = (bf16_t*)(ws + WS_CAT) + (size_t)row * DM + col;
#pragma unroll
        for (int i = 0; i < 16; ++i) o[i] = f2bf(bf2f(ys[i]) * sigmoidf_(c[i] + bglu[col + i]));
    }
};
struct EpiOut1 {
    unsigned char* ws;
    DEV void tile(const float* c, const float*, int row, bool ok, int col, int, int) const {
        if (!ok) return; const float rs = ((const float*)(ws + WS_CTL + C_RSTDS))[row]; float* o = (float*)(ws + WS_TMP) + (size_t)row * DM + col;
#pragma unroll
        for (int i = 0; i < 16; ++i) o[i] = c[i] * rs;
    }
};
struct EpiOut2 {
    unsigned char* ws; const float* x;
    DEV void tile(const float* c, const float*, int row, bool ok, int col, int, int) const {
        if (!ok) return; const float* t = (const float*)(ws + WS_TMP) + (size_t)row * DM + col; const float* xr = x + (size_t)row * DM + col;
        float* h = (float*)(ws + WS_H) + (size_t)row * DM + col; bf16_t* hb = (bf16_t*)(ws + WS_HB) + (size_t)row * DM + col;
#pragma unroll
        for (int i = 0; i < 16; ++i) { const float v = xr[i] + t[i] + c[i]; h[i] = v; hb[i] = f2bf(v); }
    }
};
struct EpiRouter {
    unsigned char* ws;
    DEV void tile(const float* c, const float*, int row, bool ok, int col, int, int) const {
        if (!ok) return; const float rs = ((const float*)(ws + WS_CTL + C_RSTDH))[row]; float* o = (float*)(ws + WS_LOGIT) + (size_t)row * NE + col;
#pragma unroll
        for (int i = 0; i < 16; ++i) o[i] = c[i] * rs;
    }
};
struct EpiGateUp {
    unsigned char* ws; int shared; int pad;
    DEV void tile(const float* c, const float* c2, int row, bool ok, int col, int, int) const {
        if (!ok) return;
        const int tok = shared ? row : ((const int*)(ws + WS_CTL + C_STOK))[row];
        const float rs = ((const float*)(ws + WS_CTL + C_RSTDH))[tok];
        bf16_t* o = (shared ? (bf16_t*)(ws + WS_HS) : (bf16_t*)(ws + WS_H1)) + (size_t)row * EH + col;
#pragma unroll
        for (int i = 0; i < 16; ++i) { const float gg = c[i] * rs, uu = c2[i] * rs; o[i] = f2bf(gg * sigmoidf_(gg) * uu); }
    }
};
struct EpiDown {
    unsigned char* ws;
    DEV void tile(const float* c, const float*, int row, bool ok, int col, int, int) const {
        if (!ok) return; const int dst = ((const int*)(ws + WS_CTL + C_SDST))[row]; if (dst < 0) return;
        const float w = ((const float*)(ws + WS_CTL + C_SW))[row]; bf16_t* o = (bf16_t*)(ws + WS_Y) + (size_t)dst * DM + col;
#pragma unroll
        for (int i = 0; i < 16; ++i) o[i] = f2bf(c[i] * w);
    }
};
struct EpiFinal {
    unsigned char* ws; float* out;
    DEV void tile(const float* c, const float*, int row, bool ok, int col, int, int) const {
        if (!ok) return; const float* h = (const float*)(ws + WS_H) + (size_t)row * DM + col; const bf16_t* y = (const bf16_t*)(ws + WS_Y) + (size_t)row * TOPK * DM + col;
#pragma unroll
        for (int i = 0; i < 16; ++i) { float v = h[i] + c[i];
#pragma unroll
            for (int k = 0; k < TOPK; ++k) v += bf2f(y[(size_t)k * DM + i]);
            out[(size_t)row * DM + col + i] = v; }
    }
};

__global__ void __launch_bounds__(256) k_attn_oracle(unsigned char* ws) {
    __shared__ float Ks[32][128];
    __shared__ float Vs[32][128];
    __shared__ float lut[LUTN];
    const int tid = threadIdx.x, h = blockIdx.y, c = tid >> 7, r = blockIdx.x * 128 + (tid & 127);
    const bf16_t* Q = (const bf16_t*)(ws + WS_Q); const bf16_t* Kb = (const bf16_t*)(ws + WS_K); const bf16_t* Vb = (const bf16_t*)(ws + WS_V);
    for (int i = tid; i < LUTN; i += 256) lut[i] = ((const float*)(ws + WS_CTL + C_LUT))[h * LUTN + i];
    float q[64];
#pragma unroll
    for (int d = 0; d < 64; ++d) q[d] = bf2f(Q[(size_t)r * QKW + h * 128 + c * 64 + d]);
    float o[128];
#pragma unroll
    for (int i = 0; i < 128; ++i) o[i] = 0.f;
    float l = 0.f;
    const int posq = 16 + r;
    for (int k0 = 0; k0 < KROWS; k0 += 32) {
        __syncthreads();
        { const int key = tid >> 3, seg = (tid & 7) * 16; const bf16_t* kp = Kb + (size_t)(k0 + key) * QKW + h * 128 + seg; const bf16_t* vp = Vb + (size_t)(k0 + key) * QKW + h * 128 + seg;
#pragma unroll
            for (int i = 0; i < 16; ++i) { Ks[key][seg + i] = bf2f(kp[i]); Vs[key][seg + i] = bf2f(vp[i]); } }
        __syncthreads();
        for (int j = 0; j < 32; ++j) {
            const int key = k0 + j; if (key >= LTOT) break;
            float s = 0.f;
#pragma unroll
            for (int d = 0; d < 64; ++d) s += q[d] * Ks[j][c * 64 + d];
            const int posk = key < T ? 16 + key : key - T; int rel = posk - posq; rel = rel < -91 ? -91 : (rel > 91 ? 91 : rel);
            const float p = exp2f(s + lut[rel + 91]);
            l += p;
#pragma unroll
            for (int i = 0; i < 128; ++i) o[i] += p * Vs[j][i];
        }
    }
    float* O = (float*)(ws + WS_OACC) + ((size_t)(r * NH + h) * 2 + c) * DV; const float il = 1.0f / l;
#pragma unroll
    for (int i = 0; i < 128; ++i) O[i] = o[i] * il;
}
__global__ void __launch_bounds__(256) k_attn_combine(In in, unsigned char* ws) {
    const int w = (blockIdx.x * 256 + threadIdx.x) >> 6, lane = threadIdx.x & 63; if (w >= T * NH) return;
    const int r = w >> 3, h = w & 7; const float lam = *(const float*)(ws + WS_CTL + C_LAM);
    const float* O = (const float*)(ws + WS_OACC) + (size_t)(r * NH + h) * 2 * DV;
    const float v0 = O[lane] - lam * O[DV + lane], v1 = O[64 + lane] - lam * O[DV + 64 + lane];
    const float ms = wave_sum(v0 * v0 + v1 * v1) * (1.0f / DV); const float rs = rsqrtf(ms + EPS) * 0.8f;
    bf16_t* o = (bf16_t*)(ws + WS_CAT) + (size_t)r * DM + SSMW + h * DV;
    o[lane] = f2bf(v0 * rs * in.subln[lane]); o[64 + lane] = f2bf(v1 * rs * in.subln[64 + lane]);
}

__global__ void __launch_bounds__(64) k_ssm_oracle(In in, unsigned char* ws) {
    __shared__ float us[TC * GP];
    __shared__ float st[2 * NST];
    const int dg = blockIdx.x, dir = dg >> 6, g = dg & 63, lane = threadIdx.x;
    const float* abar = (const float*)(ws + WS_CTL + C_SSMP); const float* bbar = abar + 2 * 64 * 64 * 2;
    const int n = lane; const int pi = dg * NST + n;
    const float ar = abar[pi * 2], ai = abar[pi * 2 + 1];
    float br[GP], bi[GP];
#pragma unroll
    for (int p = 0; p < GP; ++p) { br[p] = bbar[((size_t)pi * GP + p) * 2]; bi[p] = bbar[((size_t)pi * GP + p) * 2 + 1]; }
    const int op = lane & 15, oq = lane >> 4;
    float cr[16], ci[16];
#pragma unroll
    for (int i = 0; i < 16; ++i) { const size_t ix = ((size_t)dg * GP + op) * NST + oq * 16 + i; cr[i] = in.c_re[ix]; ci[i] = in.c_im[ix]; }
    float sr = 0.f, si = 0.f;
    const bf16_t* UX = (const bf16_t*)(ws + WS_UX) + (size_t)g * NCH * 768;
    float* Yo = (float*)(ws + (dir ? WS_YR : WS_YF));
    if (dir == 0) {
        const float* um = (const float*)(ws + WS_CTL + C_UMETA);
        for (int j = 0; j < NMETA; ++j) { float bur = 0.f, bui = 0.f;
#pragma unroll
            for (int p = 0; p < GP; ++p) { const float u = um[(size_t)j * SSMW + g * GP + p]; bur += br[p] * u; bui += bi[p] * u; }
            const float nr = ar * sr - ai * si + bur, ni = ar * si + ai * sr + bui; sr = nr; si = ni; }
    }
    for (int cc = 0; cc < NCH; ++cc) {
        const int c = dir ? NCH - 1 - cc : cc;
        __syncthreads();
        { const bf16_t* src = UX + (size_t)c * 768 + lane * 8;
#pragma unroll
            for (int i = 0; i < 8; ++i) us[lane * 8 + i] = bf2f(src[i]); }
        __syncthreads();
        for (int jj = 0; jj < TC; ++jj) {
            const int j = dir ? TC - 1 - jj : jj;
            float bur = 0.f, bui = 0.f;
#pragma unroll
            for (int p = 0; p < GP; ++p) { const float u = us[j * GP + p]; bur += br[p] * u; bui += bi[p] * u; }
            const float nr = ar * sr - ai * si + bur, ni = ar * si + ai * sr + bui; sr = nr; si = ni;
            __syncthreads();
            st[n] = sr; st[NST + n] = si;
            __syncthreads();
            float y = 0.f;
#pragma unroll
            for (int i = 0; i < 16; ++i) y += cr[i] * st[oq * 16 + i] - ci[i] * st[NST + oq * 16 + i];
            y += __shfl_xor(y, 16); y += __shfl_xor(y, 32);
            if (lane < 16) Yo[(size_t)(c * TC + j) * SSMW + g * GP + op] = y;
        }
    }
}
__global__ void __launch_bounds__(256) k_ssm_post(In in, unsigned char* ws) {
    const size_t i = (size_t)blockIdx.x * 256 + threadIdx.x; if (i >= (size_t)T * SSMW) return;
    const int r = (int)(i >> 10), cidx = (int)(i & 1023), g = cidx >> 4, p = cidx & 15;
    const float u = bf2f(((const bf16_t*)(ws + WS_UX))[((size_t)g * NCH + (r >> 5)) * 768 + (r & 31) * 16 + p]);
    const float y = in.ssm_d[cidx] * u + ((const float*)(ws + WS_YF))[i] + ((const float*)(ws + WS_YR))[i];
    ((bf16_t*)(ws + WS_YS))[i] = f2bf(gelu_tanh(y));
}
__global__ void __launch_bounds__(256) k_rstd_ssm(unsigned char* ws) {
    const int w = (blockIdx.x * 256 + threadIdx.x) >> 6, lane = threadIdx.x & 63; if (w >= T) return;
    const bf16_t* c = (const bf16_t*)(ws + WS_CAT) + (size_t)w * DM; float ss = 0.f;
    for (int j = 0; j < SSMW / 64; ++j) { const float v = bf2f(c[j * 64 + lane]); ss += v * v; }
    ss = wave_sum(ss); if (lane == 0) ((float*)(ws + WS_CTL + C_RSTDS))[w] = rsqrtf(ss * (1.0f / SSMW) + EPS);
}
__global__ void __launch_bounds__(256) k_rstd_h(unsigned char* ws) {
    const int w = (blockIdx.x * 256 + threadIdx.x) >> 6, lane = threadIdx.x & 63; if (w >= T) return;
    const float* h = (const float*)(ws + WS_H) + (size_t)w * DM; float ss = 0.f;
    for (int j = 0; j < DM / 64; ++j) { const float v = h[j * 64 + lane]; ss += v * v; }
    ss = wave_sum(ss); if (lane == 0) ((float*)(ws + WS_CTL + C_RSTDH))[w] = rsqrtf(ss * (1.0f / DM) + EPS);
}

__global__ void __launch_bounds__(256) k_route(In in, unsigned char* ws) {
    const int t = (blockIdx.x * 256 + threadIdx.x) >> 6, lane = threadIdx.x & 63; if (t >= T) return;
    const float score = sigmoidf_(((const float*)(ws + WS_LOGIT))[(size_t)t * NE + lane]);
    const float choice = score + in.router_bias[lane];
    float m1 = choice;
#pragma unroll
    for (int o = 1; o < 8; o <<= 1) m1 = fmaxf(m1, __shfl_xor(m1, o));
    const unsigned long long b1 = __ballot(choice == m1); const int gbase = lane & ~7;
    const unsigned gb = (unsigned)((b1 >> gbase) & 0xffull); const int first = gbase + __builtin_ctz(gb);
    float m2 = (lane == first) ? -INFINITY : choice;
#pragma unroll
    for (int o = 1; o < 8; o <<= 1) m2 = fmaxf(m2, __shfl_xor(m2, o));
    const float gs = m1 + m2;
    int grank = 0; const int myg = lane >> 3;
#pragma unroll
    for (int j = 0; j < 8; ++j) { const float o = __shfl(gs, j * 8); grank += (o > gs || (o == gs && j < myg)) ? 1 : 0; }
    const float mv = grank < 4 ? choice : -INFINITY;
    int rank = 0;
    for (int j = 0; j < 64; ++j) { const float o = __shfl(mv, j); rank += (o > mv || (o == mv && j < lane)) ? 1 : 0; }
    const bool sel = rank < TOPK;
    const float ssum = wave_sum(sel ? score : 0.f);
    if (sel) {
        const int pos = atomicAdd((int*)(ws + WS_CTL + C_CNT) + lane, 1);
        ((int*)(ws + WS_CTL + C_IDX))[t * TOPK + rank] = lane;
        ((float*)(ws + WS_CTL + C_WTS))[t * TOPK + rank] = score / ssum * 2.5f;
        ((int*)(ws + WS_CTL + C_POS))[t * TOPK + rank] = pos;
    }
}
__global__ void __launch_bounds__(256) k_offsets(unsigned char* ws) {
    const int tid = blockIdx.x * 256 + threadIdx.x, nthr = gridDim.x * 256;
    if (tid == 0) { const int* cnt = (const int*)(ws + WS_CTL + C_CNT); int* off = (int*)(ws + WS_CTL + C_OFF); int a = 0;
        for (int e = 0; e < NE; ++e) { off[e] = a; a += (cnt[e] + 255) & ~255; } off[NE] = a; }
    int* stok = (int*)(ws + WS_CTL + C_STOK); int* sdst = (int*)(ws + WS_CTL + C_SDST); float* sw = (float*)(ws + WS_CTL + C_SW);
    for (int i = tid; i < NSLOT; i += nthr) { stok[i] = 0; sdst[i] = -1; sw[i] = 0.f; }
    for (int i = tid; i < T; i += nthr) stok[NSLOT + i] = i;
}
__global__ void __launch_bounds__(256) k_scatter(unsigned char* ws) {
    const int i = blockIdx.x * 256 + threadIdx.x; if (i >= T * TOPK) return;
    const int e = ((const int*)(ws + WS_CTL + C_IDX))[i]; const int slot = ((const int*)(ws + WS_CTL + C_OFF))[e] + ((const int*)(ws + WS_CTL + C_POS))[i];
    ((int*)(ws + WS_CTL + C_STOK))[slot] = i >> 3; ((int*)(ws + WS_CTL + C_SDST))[slot] = i; ((float*)(ws + WS_CTL + C_SW))[slot] = ((const float*)(ws + WS_CTL + C_WTS))[i];
}

namespace pg8 {
#define PG8_LAS __attribute__((address_space(3)))
typedef short bf16x8 __attribute__((ext_vector_type(8)));
typedef float f32x4 __attribute__((ext_vector_type(4)));
typedef float f32x2 __attribute__((ext_vector_type(2)));
typedef unsigned u32x4 __attribute__((ext_vector_type(4)));
constexpr int BM = 256, BK = 64, HALF = 128, HTB = HALF * BK * 2, STAGE_BYTES = 8 * HTB, NXCD = 8, WGM = 8;
__host__ __device__ __forceinline__ int lds_byte(int r, int c) { const int st = (r >> 4) * 2 + (c >> 5), rr = r & 15, cc = c & 31, ob = rr * 64 + cc * 2; return st * 1024 + (ob ^ (((ob >> 9) & 1) << 5)); }
__host__ __device__ __forceinline__ void stage_rc(int b, int& R, int& C) { const int st = b / 1024, sb = b % 1024, swz = sb ^ (((sb >> 9) & 1) << 5); R = (st >> 1) * 16 + swz / 64; C = (st & 1) * 32 + (swz % 64) / 2; }
__host__ __device__ __forceinline__ int perm32(int rho) { const int n = rho >> 4, i = rho & 15; return 8 * (i >> 2) + 4 * n + (i & 3); }
__device__ __forceinline__ unsigned cvt_pk_bf16(float lo, float hi) { unsigned r; asm volatile("v_cvt_pk_bf16_f32 %0, %1, %2" : "=v"(r) : "v"(lo), "v"(hi)); return r; }

struct Unit { const char* A; const char* B; int pm, pn, e, slot0; };

template <class Epi, class Sched, bool GATHER, bool ALIGN_EPI>
__device__ __forceinline__ void gemm_phase(PG8_LAS unsigned char* lds, const int lda, const int ldb, const int K, const Sched& S, const Epi& E, const int* __restrict__ rows) {
    const int tid = threadIdx.x, wid = __builtin_amdgcn_readfirstlane(tid >> 6), lane = tid & 63, wr = wid >> 2, wc = wid & 3, fr = lane & 15, fq = lane >> 4;
    const int nt = K / BK;
    int Rs[2], Cs[2]; unsigned voffB[2];
#pragma unroll
    for (int i = 0; i < 2; ++i) { stage_rc(tid * 16 + i * 8192, Rs[i], Cs[i]); const int Rb = (Rs[i] & ~31) + perm32(Rs[i] & 31); voffB[i] = (unsigned)(Rb * ldb + Cs[i]) * 2u; }
    const size_t kstep = (size_t)(BK * 2);
    const size_t hstepB = (size_t)HALF * ldb * 2;
    const unsigned ldsw = (unsigned)wid * 1024u;
    const int aoff = lds_byte(wr * 64 + fr, fq * 8), boff = lds_byte(wc * 32 + fr, fq * 8);
#define PG8_SA(b, h) (((b) * 2 + (h)) * HTB)
#define PG8_SB(b, h) ((4 + (b) * 2 + (h)) * HTB)
#define PG8_STAGE(bufoff, gbase, voff) do { _Pragma("unroll") for (int _i = 0; _i < 2; ++_i) \
        __builtin_amdgcn_global_load_lds((const unsigned*)((const char*)(gbase) + (voff)[_i]), (PG8_LAS unsigned*)(lds + (bufoff) + ldsw + _i * 8192), 16, 0, 0); } while (0)
#define PG8_LDA(dst, b, h) do { _Pragma("unroll") for (int m = 0; m < 4; ++m) _Pragma("unroll") for (int k = 0; k < 2; ++k) dst[m][k] = *(const PG8_LAS bf16x8*)(lds + PG8_SA(b, h) + aoff + m * 2048 + k * 1024); } while (0)
#define PG8_LDB(dst, b, h) do { _Pragma("unroll") for (int n = 0; n < 2; ++n) _Pragma("unroll") for (int k = 0; k < 2; ++k) dst[n][k] = *(const PG8_LAS bf16x8*)(lds + PG8_SB(b, h) + boff + n * 2048 + k * 1024); } while (0)
#define PG8_MMA(ai, bj, At, Bt) do { __builtin_amdgcn_s_setprio(1); _Pragma("unroll") for (int m = 0; m < 4; ++m) _Pragma("unroll") for (int n = 0; n < 2; ++n) _Pragma("unroll") for (int k = 0; k < 2; ++k) \
        acc[ai][bj][m][n] = __builtin_amdgcn_mfma_f32_16x16x32_bf16(Bt[n][k], At[m][k], acc[ai][bj][m][n], 0, 0, 0); __builtin_amdgcn_s_setprio(0); } while (0)
#define PG8_WAIT_V(n) asm volatile("s_waitcnt vmcnt(" #n ")" ::: "memory")
#define PG8_WAIT_L(n) asm volatile("s_waitcnt lgkmcnt(" #n ")" ::: "memory")
#define PG8_BAR __builtin_amdgcn_s_barrier()
#define PG8_SCHED __builtin_amdgcn_sched_barrier(0)
#define PG8_SETVA(v, u) do { _Pragma("unroll") for (int _h = 0; _h < 2; ++_h) _Pragma("unroll") for (int _i = 0; _i < 2; ++_i) { \
        const int _row = _h * HALF + Rs[_i]; const unsigned _src = GATHER ? (unsigned)rows[(u).slot0 + _row] : (unsigned)_row; (v)[_h][_i] = (_src * (unsigned)lda + (unsigned)Cs[_i]) * 2u; } } while (0)
    Unit cur, nxt; int ui = 0;
    if (!S.next(0, cur)) return;
    f32x4 acc[2][2][4][2];
#pragma unroll
    for (int a = 0; a < 2; ++a)
#pragma unroll
        for (int b = 0; b < 2; ++b)
#pragma unroll
            for (int m = 0; m < 4; ++m)
#pragma unroll
                for (int n = 0; n < 2; ++n) acc[a][b][m][n] = (f32x4){0.f, 0.f, 0.f, 0.f};
    bf16x8 At[4][2], B0[2][2], B1[2][2];
    unsigned vc[2][2], vn[2][2];
    PG8_SETVA(vc, cur);
    const char* cA = cur.A; const char* cB = cur.B;
    PG8_STAGE(PG8_SB(0, 0), cB, voffB); PG8_STAGE(PG8_SB(0, 1), cB + hstepB, voffB); PG8_STAGE(PG8_SA(0, 0), cA, vc[0]); PG8_STAGE(PG8_SA(0, 1), cA, vc[1]);
    if (wr == 1) PG8_BAR;
    PG8_WAIT_V(2); PG8_BAR;
    PG8_STAGE(PG8_SB(1, 0), cB + kstep, voffB); PG8_STAGE(PG8_SA(1, 0), cA + kstep, vc[0]); PG8_STAGE(PG8_SB(1, 1), cB + hstepB + kstep, voffB);
    PG8_WAIT_V(6); PG8_BAR;
    for (;;) {
        const bool has_next = S.next(ui + 1, nxt);
        const char* nA = has_next ? nxt.A : cA; const char* nB = has_next ? nxt.B : cB;
        if (GATHER && has_next) { PG8_SETVA(vn, nxt); }
        else {
#pragma unroll
            for (int h = 0; h < 2; ++h)
#pragma unroll
                for (int i = 0; i < 2; ++i) vn[h][i] = vc[h][i]; }
        for (int t = 0; t < nt; t += 2) {
            const bool last = (t == nt - 2);
            const char* a1 = cA + (size_t)(t + 1) * kstep;
            const char* a2 = last ? nA : cA + (size_t)(t + 2) * kstep; const char* b2 = last ? nB : cB + (size_t)(t + 2) * kstep;
            const char* a3 = a2 + kstep; const char* b3 = b2 + kstep;
            unsigned v2[2][2];
#pragma unroll
            for (int h = 0; h < 2; ++h)
#pragma unroll
                for (int i = 0; i < 2; ++i) v2[h][i] = last ? vn[h][i] : vc[h][i];
            if constexpr (Epi::MIDK_T > 0) { if (t == Epi::MIDK_T) E.midk(acc, cur, wr, wc, fr, fq); }
            PG8_LDB(B0, 0, 0); PG8_LDB(B1, 0, 1); PG8_SCHED; PG8_LDA(At, 0, 0); PG8_STAGE(PG8_SA(1, 1), a1, vc[1]);
            PG8_WAIT_V(8); PG8_WAIT_L(0); PG8_BAR; PG8_MMA(0, 0, At, B0); PG8_MMA(0, 1, At, B1); PG8_BAR; PG8_SCHED;
            PG8_LDA(At, 0, 1); PG8_STAGE(PG8_SB(0, 0), b2, voffB); PG8_STAGE(PG8_SB(0, 1), b2 + hstepB, voffB); PG8_STAGE(PG8_SA(0, 0), a2, v2[0]);
            PG8_WAIT_V(8); PG8_WAIT_L(0); PG8_BAR; PG8_MMA(1, 0, At, B0); PG8_MMA(1, 1, At, B1); PG8_BAR; PG8_SCHED;
            PG8_LDB(B0, 1, 0); PG8_LDB(B1, 1, 1); PG8_SCHED; PG8_LDA(At, 1, 0); PG8_STAGE(PG8_SA(0, 1), a2, v2[1]);
            PG8_WAIT_V(8); PG8_WAIT_L(0); PG8_BAR; PG8_MMA(0, 0, At, B0); PG8_MMA(0, 1, At, B1); PG8_BAR; PG8_SCHED;
            PG8_LDA(At, 1, 1); PG8_STAGE(PG8_SB(1, 0), b3, voffB); PG8_STAGE(PG8_SB(1, 1), b3 + hstepB, voffB); PG8_STAGE(PG8_SA(1, 0), a3, v2[0]);
            PG8_WAIT_V(8); PG8_WAIT_L(0); PG8_BAR; PG8_MMA(1, 0, At, B0); PG8_MMA(1, 1, At, B1); PG8_BAR; PG8_SCHED;
        }
        if constexpr (ALIGN_EPI) { if (wr == 0) PG8_BAR; }
        E(acc, cur, wr, wc, fr, fq);
        if (!has_next) break;
#pragma unroll
        for (int a = 0; a < 2; ++a)
#pragma unroll
            for (int b = 0; b < 2; ++b)
#pragma unroll
                for (int m = 0; m < 4; ++m)
#pragma unroll
                    for (int n = 0; n < 2; ++n) acc[a][b][m][n] = (f32x4){0.f, 0.f, 0.f, 0.f};
        cur = nxt; cA = nA; cB = nB; ++ui;
#pragma unroll
        for (int h = 0; h < 2; ++h)
#pragma unroll
            for (int i = 0; i < 2; ++i) vc[h][i] = vn[h][i];
        if constexpr (ALIGN_EPI) { if (wr == 1) PG8_BAR; }
    }
    PG8_WAIT_V(0);
    if constexpr (!ALIGN_EPI) { if (wr == 0) PG8_BAR; }
    PG8_BAR;
#undef PG8_SA
#undef PG8_SB
#undef PG8_STAGE
#undef PG8_LDA
#undef PG8_LDB
#undef PG8_MMA
#undef PG8_SETVA
}

struct DenseOrder {
    const char* A; const char* B; size_t astep, bstep; int nM, nN, nwg, G, c;
    __device__ __forceinline__ void init(const void* A_, size_t astep_, const void* B_, size_t bstep_, int nM_, int nN_, int G_, int c_) { A = (const char*)A_; B = (const char*)B_; astep = astep_; bstep = bstep_; nM = nM_; nN = nN_; nwg = nM * nN; G = G_; c = c_; }
    __device__ __forceinline__ bool next(int i, Unit& u) const {
        const long L = (long)i * G + c; if (L >= nwg) return false;
        int wgid = (int)L; { const int q = nwg / NXCD, r = nwg % NXCD, xcd = wgid % NXCD, off = wgid / NXCD; wgid = (xcd < r ? xcd * (q + 1) : r * (q + 1) + (xcd - r) * q) + off; }
        const int nig = WGM * nN, gid = wgid / nig, fm = gid * WGM, gsz = (nM - fm) < WGM ? (nM - fm) : WGM;
        u.pm = fm + ((wgid % nig) % gsz); u.pn = (wgid % nig) / gsz; u.e = 0; u.slot0 = 0;
        u.A = A + (size_t)u.pm * astep; u.B = B + (size_t)u.pn * bstep; return true;
    }
};
}

namespace att {
typedef short bf16x8 __attribute__((ext_vector_type(8)));
typedef short s16x4 __attribute__((ext_vector_type(4)));
typedef float f32x16 __attribute__((ext_vector_type(16)));
typedef unsigned u32x4 __attribute__((ext_vector_type(4)));
typedef float f32x2_t __attribute__((ext_vector_type(2))); typedef __bf16 bf16x2_t __attribute__((ext_vector_type(2)));
typedef short v4i16_t __attribute__((ext_vector_type(4)));
typedef __attribute__((address_space(3))) const char* lds_cptr;
constexpr int SLOTB = 16384, NTILE = 257;
constexpr int LDS_K = 0, LDS_V = 3 * SLOTB, LDS_Q = 6 * SLOTB, LDS_WS = 131072 + 1024, LDS_LUT = LDS_WS + 2048, LDS_END = LDS_LUT + 1024;
constexpr int LDS_EX = 0, EXPITCH = 132, LDS_STG = 4 * 32 * EXPITCH * 4;
static_assert(LDS_STG + 4 * 8192 <= 131072, "attention epilogue overlay stays inside the ring region");
__device__ __forceinline__ int crow(int r, int hi) { return (r & 3) + 8 * (r >> 2) + 4 * hi; }
#define SBAR() __builtin_amdgcn_sched_barrier(0)
__device__ __forceinline__ void glds16(const void* gsrc, unsigned lds_dst) { unsigned keep;
    asm volatile("s_mov_b32 %0, m0\n\ts_mov_b32 m0, %2\n\ts_nop 0\n\tglobal_load_lds_dwordx4 %1, off\n\ts_mov_b32 m0, %0" : "=&s"(keep) : "v"(gsrc), "s"(lds_dst) : "memory"); }
__device__ __forceinline__ unsigned cvtpk_s(float lo, float hi) { f32x2_t v = {lo, hi}; bf16x2_t b = __builtin_convertvector(v, bf16x2_t); return __builtin_bit_cast(unsigned, b); }
#define WAIT_BAR(N) asm volatile("s_waitcnt vmcnt(" #N ") lgkmcnt(0)\n\ts_barrier" ::: "memory")
__device__ __forceinline__ void kload8(bf16x8* kf, lds_cptr kp) {
    kf[0] = *(const __attribute__((address_space(3))) bf16x8*)(kp);        kf[1] = *(const __attribute__((address_space(3))) bf16x8*)(kp + 512);
    kf[2] = *(const __attribute__((address_space(3))) bf16x8*)(kp + 2048); kf[3] = *(const __attribute__((address_space(3))) bf16x8*)(kp + 2560);
    kf[4] = *(const __attribute__((address_space(3))) bf16x8*)(kp + 4096); kf[5] = *(const __attribute__((address_space(3))) bf16x8*)(kp + 4608);
    kf[6] = *(const __attribute__((address_space(3))) bf16x8*)(kp + 6144); kf[7] = *(const __attribute__((address_space(3))) bf16x8*)(kp + 6656);
}
__device__ __forceinline__ void kload2(bf16x8* kf, lds_cptr kp, int j) { kf[2 * j] = *(const __attribute__((address_space(3))) bf16x8*)(kp + j * 2048); kf[2 * j + 1] = *(const __attribute__((address_space(3))) bf16x8*)(kp + j * 2048 + 512); }
__device__ __forceinline__ s16x4 vtr(lds_cptr p) { return __builtin_bit_cast(s16x4, __builtin_amdgcn_ds_read_tr16_b64_v4i16((__attribute__((address_space(3))) v4i16_t*)p)); }

__device__ __forceinline__ void add_bias(f32x16& C0, f32x16& C1, int s, int qrow, int hi, const __attribute__((address_space(3))) float* lutl) {
#pragma unroll
    for (int r = 0; r < 16; ++r) {
#pragma unroll
        for (int half = 0; half < 2; ++half) {
            const int kk = crow(r, hi) + 32 * half;
            float add;
            if (s == NTILE - 1) { int rel = kk - 16 - qrow; rel = rel < -91 ? -91 : rel; add = kk < NMETA ? lutl[rel + 91] : -INFINITY; }
            else { int rel = 64 * s + kk - qrow; rel = rel < -91 ? -91 : (rel > 91 ? 91 : rel); add = lutl[rel + 91]; }
            if (half == 0) C0[r] += add; else C1[r] += add;
        }
    }
}

__device__ __forceinline__ void attn_unit(int h, int qb, const bf16_t* Q, const bf16_t* __restrict__ K, const bf16_t* __restrict__ V, bf16_t* CAT, char* shm, float lam, const float* subln, float f1) {
    const int tid = threadIdx.x, lane = tid & 63, r32 = lane & 31, hi = lane >> 5; const int wid = __builtin_amdgcn_readfirstlane(tid >> 6);
    const int c = wid >> 2, wq = wid & 3;
    const int q0 = qb * 128, qrow = q0 + wq * 32 + r32;
    const unsigned lds0 = (unsigned)(uintptr_t)shm;
    const lds_cptr shm3 = (lds_cptr)shm;
    float* wsf = (float*)(shm + LDS_WS) + wid * 64;
    const __attribute__((address_space(3))) float* lutl = (const __attribute__((address_space(3))) float*)((lds_cptr)shm + LDS_LUT);
    const bf16_t* ksrc = K + (size_t)lane * QKW + h * 128 + wid * 8;
    const bf16_t* vsrc = V + (size_t)(16 * (wid & 3) + (lane >> 2)) * QKW + h * 128 + (wid >> 2) * 32 + (lane & 3) * 8;
    const unsigned kdst = lds0 + LDS_K + wid * 1024, vdst = lds0 + LDS_V + (wid >> 2) * 4096 + (wid & 3) * 1024;
#define TCL(t) ((t) < NTILE ? (t) : NTILE - 1)
#define DMA_K1(t, slot, m) do { const bf16_t* _p = ksrc + (size_t)TCL(t) * 64 * QKW + (m) * 64; glds16(_p, (unsigned)__builtin_amdgcn_readfirstlane(kdst + (m) * 8192 + (slot))); } while (0)
#define DMA_V1(t, slot, m) do { const bf16_t* _p = vsrc + (size_t)TCL(t) * 64 * QKW + (m) * 64; glds16(_p, (unsigned)__builtin_amdgcn_readfirstlane(vdst + (m) * 8192 + (slot))); } while (0)
#define DMA_K(t, slot) do { DMA_K1(t, slot, 0); DMA_K1(t, slot, 1); } while (0)
#define DMA_V(t, slot) do { DMA_V1(t, slot, 0); DMA_V1(t, slot, 1); } while (0)
    const lds_cptr kp0 = shm3 + LDS_K + c * 8192 + hi * 1024 + r32 * 16;
    const lds_cptr vp0 = shm3 + LDS_V + ((lane >> 4) & 1) * 32 + (lane & 3) * 8 + (4 * hi + ((lane & 15) >> 2)) * 64;
    const int near_lo = (2 * qb - 2) < 0 ? 0 : 2 * qb - 2, near_hi = (2 * qb + 3) > 255 ? 255 : 2 * qb + 3;
#define NEAR(s) (((s) >= near_lo && (s) <= near_hi) || (s) == NTILE - 1)
    DMA_K(0, 0); DMA_V(0, 0); DMA_K(1, SLOTB); DMA_K(2, 2 * SLOTB);
    { const bf16_t* Qw = Q + (size_t)(q0 + wq * 32 + (lane & 31)) * QKW + h * 128 + c * 64 + (lane >> 5) * 8;
      const unsigned qdst = lds0 + LDS_Q + wid * 4096;
#pragma unroll
      for (int p = 0; p < 4; ++p) glds16(Qw + p * 16, (unsigned)__builtin_amdgcn_readfirstlane(qdst + p * 1024)); }
    const lds_cptr qp0 = shm3 + LDS_Q + wid * 4096 + hi * 512 + r32 * 16;
#define QF(d0) (*(const __attribute__((address_space(3))) bf16x8*)(qp0 + (d0) * 1024))
    float l_reg = 0.f; f32x16 o[4]; o[0] = f32x16{}; o[1] = f32x16{}; o[2] = f32x16{}; o[3] = f32x16{};
    const f32x16 zero16 = f32x16{};
    f32x16 pA0, pA1, pB0, pB1; bf16x8 kf[8]; bf16x8 qfa, qfb;
    int sl_prev = 0, sl_cur = 0, sl_next = SLOTB;
#define ROT() do { sl_prev = sl_cur; sl_cur = sl_next; sl_next = (sl_next == 2 * SLOTB) ? 0 : sl_next + SLOTB; } while (0)
    WAIT_BAR(0);
    kload8(kf, kp0);
#pragma unroll
    for (int d0 = 0; d0 < 4; ++d0) { pA0 = __builtin_amdgcn_mfma_f32_32x32x16_bf16(kf[2 * d0], QF(d0), d0 == 0 ? zero16 : pA0, 0, 0, 0); pA1 = __builtin_amdgcn_mfma_f32_32x32x16_bf16(kf[2 * d0 + 1], QF(d0), d0 == 0 ? zero16 : pA1, 0, 0, 0); }
    if (NEAR(0)) add_bias(pA0, pA1, 0, qrow, hi, lutl);
#pragma unroll
    for (int r = 0; r < 16; ++r) { pA0[r] = __builtin_amdgcn_exp2f(pA0[r]); pA1[r] = __builtin_amdgcn_exp2f(pA1[r]); }
    WAIT_BAR(0);
    DMA_K(3, 0); DMA_V(1, SLOTB);
    ROT();
    kload8(kf, kp0 + sl_cur); qfa = QF(0);
    WAIT_BAR(4);
    s16x4 vlo[16], vhi[16]; u32x4 pw0, pw1, pw2, pw3;
#define PKW(P, B) cvtpk_s(P[B], P[B + 1])
#define PAF(k) __builtin_bit_cast(bf16x8, pw##k)
#define VFR(i) (bf16x8){vlo[i][0], vlo[i][1], vlo[i][2], vlo[i][3], vhi[i][0], vhi[i][1], vhi[i][2], vhi[i][3]}
#define PIN(x) asm volatile("" : "+v"(x))
#define GAPA(MF, A0, A1, A2, A3, W0, W1, PW) do { MF; sacc += A0; sacc += A1; sacc += A2; sacc += A3; PIN(sacc); W0; W1; PIN(PW); SBAR(); } while (0)
#define EX(v) __builtin_amdgcn_exp2f(v)
#define VRD(i) do { vlo[i] = vtr(vp_ + (((i) >> 2) * 4096 + ((i) & 3) * 1024)); vhi[i] = vtr(vp_ + (((i) >> 2) * 4096 + ((i) & 3) * 1024 + 512)); SBAR(); } while (0)
#define KRD(j) do { kload2(kf, kp0 + sl_next, j); SBAR(); } while (0)
#define MF32 __builtin_amdgcn_mfma_f32_32x32x16_bf16
#define PVG(id, X, B, nid) do { o[(id) >> 2] = MF32(PAF_((id) & 3), VFR(id), o[(id) >> 2], 0, 0, 0); X[B] = EX(X[B]); X[B + 1] = EX(X[B + 1]); PIN(X); SBAR(); if ((nid) >= 0) VRD((nid) < 0 ? 0 : (nid)); } while (0)
#define PAF_(k) ((k) == 0 ? PAF(0) : (k) == 1 ? PAF(1) : (k) == 2 ? PAF(2) : PAF(3))
#define STEP(C0, C1, P0, P1, s) do { SBAR(); \
    const lds_cptr vp_ = vp0 + sl_prev; \
    float sacc = (P0[0] + P0[1]); \
    GAPA(C0 = MF32(kf[0], qfa, zero16, 0, 0, 0); qfb = QF(1), P0[2], P0[3], P0[4], P0[5],     pw0[0] = PKW(P0, 0), pw0[1] = PKW(P0, 2), pw0); \
    GAPA(C1 = MF32(kf[1], qfa, zero16, 0, 0, 0), P0[6], P0[7], P0[8], P0[9],     pw0[2] = PKW(P0, 4), pw0[3] = PKW(P0, 6), pw0); \
    GAPA(C0 = MF32(kf[2], qfb, C0, 0, 0, 0); qfa = QF(2),   P0[10], P0[11], P0[12], P0[13], pw1[0] = PKW(P0, 8), pw1[1] = PKW(P0, 10), pw1); \
    GAPA(C1 = MF32(kf[3], qfb, C1, 0, 0, 0),   P0[14], P0[15], P1[0], P1[1],   pw1[2] = PKW(P0, 12), pw1[3] = PKW(P0, 14), pw1); \
    VRD(0); GAPA(C0 = MF32(kf[4], qfa, C0, 0, 0, 0); qfb = QF(3),   P1[2], P1[3], P1[4], P1[5],     pw2[0] = PKW(P1, 0), pw2[1] = PKW(P1, 2), pw2); \
    VRD(4); GAPA(C1 = MF32(kf[5], qfa, C1, 0, 0, 0),   P1[6], P1[7], P1[8], P1[9],     pw2[2] = PKW(P1, 4), pw2[3] = PKW(P1, 6), pw2); \
    VRD(1); GAPA(C0 = MF32(kf[6], qfb, C0, 0, 0, 0),   P1[10], P1[11], P1[12], P1[13], pw3[0] = PKW(P1, 8), pw3[1] = PKW(P1, 10), pw3); \
    VRD(5); GAPA(C1 = MF32(kf[7], qfb, C1, 0, 0, 0),   P1[14], P1[15], 0.f, 0.f,       pw3[2] = PKW(P1, 12), pw3[3] = PKW(P1, 14), pw3); \
    l_reg += sacc; \
    if (NEAR(s)) add_bias(C0, C1, (s), qrow, hi, lutl); \
    SBAR(); \
    PVG(0, C0, 0, 2);   PVG(4, C0, 2, 6);   DMA_K1((s) + 3, sl_cur, 0); SBAR(); PVG(1, C0, 4, 3);   PVG(5, C0, 6, 7); \
    PVG(2, C0, 8, 8);   PVG(6, C0, 10, 12); DMA_K1((s) + 3, sl_cur, 1); SBAR(); PVG(3, C0, 12, 9);  PVG(7, C0, 14, 13); \
    PVG(8, C1, 0, 10);  PVG(12, C1, 2, 14); DMA_V1((s) + 1, sl_next, 0); SBAR(); \
    KRD(0); PVG(9, C1, 4, 11);  KRD(1); PVG(13, C1, 6, 15); \
    KRD(2); PVG(10, C1, 8, -1); DMA_V1((s) + 1, sl_next, 1); SBAR(); KRD(3); PVG(14, C1, 10, -1); \
    PVG(11, C1, 12, -1); qfa = QF(0); SBAR(); PVG(15, C1, 14, -1); \
    if ((s) == near_lo && near_lo > 0) { l_reg *= f1; _Pragma("unroll") for (int d_ = 0; d_ < 4; ++d_) _Pragma("unroll") for (int r = 0; r < 16; ++r) o[d_][r] *= f1; } \
    } while (0)
    for (int s = 1; s + 1 < NTILE; s += 2) {
        STEP(pB0, pB1, pA0, pA1, s);     WAIT_BAR(4); ROT();
        STEP(pA0, pA1, pB0, pB1, s + 1); WAIT_BAR(4); ROT();
    }
    { float sacc = pA0[0] + pA0[1];
#pragma unroll
      for (int r = 2; r < 16; ++r) sacc += pA0[r];
#pragma unroll
      for (int r = 0; r < 16; ++r) sacc += pA1[r];
      l_reg += sacc;
      pw0 = (u32x4){PKW(pA0, 0), PKW(pA0, 2), PKW(pA0, 4), PKW(pA0, 6)}; pw1 = (u32x4){PKW(pA0, 8), PKW(pA0, 10), PKW(pA0, 12), PKW(pA0, 14)};
      pw2 = (u32x4){PKW(pA1, 0), PKW(pA1, 2), PKW(pA1, 4), PKW(pA1, 6)}; pw3 = (u32x4){PKW(pA1, 8), PKW(pA1, 10), PKW(pA1, 12), PKW(pA1, 14)};
      SBAR();
      const lds_cptr vp_ = vp0 + sl_prev;
#pragma unroll
      for (int d0 = 0; d0 < 4; ++d0) {
          s16x4 lo[4], hh[4];
#pragma unroll
          for (int ks = 0; ks < 4; ++ks) { lo[ks] = vtr(vp_ + (d0 * 4096 + ks * 1024)); hh[ks] = vtr(vp_ + (d0 * 4096 + ks * 1024 + 512)); }
#define PK_(k) (bf16x8){lo[k][0], lo[k][1], lo[k][2], lo[k][3], hh[k][0], hh[k][1], hh[k][2], hh[k][3]}
          o[d0] = MF32(PAF(0), PK_(0), o[d0], 0, 0, 0); o[d0] = MF32(PAF(1), PK_(1), o[d0], 0, 0, 0);
          o[d0] = MF32(PAF(2), PK_(2), o[d0], 0, 0, 0); o[d0] = MF32(PAF(3), PK_(3), o[d0], 0, 0, 0);
#undef PK_
      } }
    int lane_e = lane; asm volatile("" : "+v"(lane_e));
    const int r32e = lane_e & 31, hie = lane_e >> 5;
    { auto rr = __builtin_amdgcn_permlane32_swap(__float_as_uint(l_reg), __float_as_uint(l_reg), false, false); l_reg = __uint_as_float(rr[0]) + __uint_as_float(rr[1]); }
    if (hie == 0) wsf[r32e] = l_reg;
    asm volatile("s_waitcnt lgkmcnt(0)" ::: "memory");
    float rli[16];
    { const float sc = c ? lam : 1.0f;
#pragma unroll
      for (int r = 0; r < 16; ++r) rli[r] = sc * __builtin_amdgcn_rcpf(wsf[crow(r, hie)]); }
    WAIT_BAR(0);
    float* ex = (float*)(shm + LDS_EX) + wq * 32 * EXPITCH;
    if (c == 1) {
#pragma unroll
        for (int r = 0; r < 16; ++r)
#pragma unroll
            for (int d0 = 0; d0 < 4; ++d0) ex[crow(r, hie) * EXPITCH + d0 * 32 + r32e] = o[d0][r] * rli[r];
    }
    WAIT_BAR(0);
    if (c == 0) {
        bf16_t* stg = (bf16_t*)(shm + LDS_STG) + wq * 4096;
        float sg[4];
#pragma unroll
        for (int d0 = 0; d0 < 4; ++d0) sg[d0] = subln[d0 * 32 + r32e] * 0.8f;
#pragma unroll
        for (int r = 0; r < 16; ++r) {
            float v[4], ss = 0.f;
#pragma unroll
            for (int d0 = 0; d0 < 4; ++d0) { v[d0] = o[d0][r] * rli[r] - ex[crow(r, hie) * EXPITCH + d0 * 32 + r32e]; ss += v[d0] * v[d0]; }
            ss += __shfl_xor(ss, 1); ss += __shfl_xor(ss, 2); ss += __shfl_xor(ss, 4); ss += __shfl_xor(ss, 8); ss += __shfl_xor(ss, 16);
            const float rn = rsqrtf(ss * (1.0f / DV) + EPS);
#pragma unroll
            for (int d0 = 0; d0 < 4; ++d0) stg[crow(r, hie) * 128 + d0 * 32 + r32e] = f2bf(v[d0] * rn * sg[d0]);
        }
        asm volatile("s_waitcnt lgkmcnt(0)" ::: "memory");
        bf16_t* Ow = CAT + (size_t)(q0 + wq * 32) * DM + SSMW + h * DV;
#pragma unroll
        for (int i = 0; i < 8; ++i) { const int row = i * 4 + (lane_e >> 4), ch = lane_e & 15; const u32x4 v = *(const u32x4*)(stg + row * 128 + ch * 8); *(u32x4*)(Ow + (size_t)row * DM + ch * 8) = v; }
    }
    WAIT_BAR(0);
#undef TCL
#undef DMA_K
#undef DMA_V
#undef DMA_K1
#undef DMA_V1
#undef NEAR
#undef ROT
#undef PKW
#undef PAF
#undef VFR
#undef PIN
#undef GAPA
#undef EX
#undef VRD
#undef PVG
#undef PAF_
#undef KRD
#undef MF32
#undef QF
#undef STEP
}
#undef SBAR
#undef WAIT_BAR
}

#define GAS __attribute__((address_space(1)))
#define LAS __attribute__((address_space(3)))
#define XB_TMO      128
#define XB_XCNT(j)  (256  + 64 * (j))
#define XB_XSUB(j)  (1280 + 64 * (j))
#define XB_XGEN(j)  (2304 + 64 * (j))
#define XB_TOP      3328
#define XB_TOPGEN   3392
#define XCD_BAR_WORDS 3456
#define XB_SPIN_CAP (1u << 18)
__device__ __forceinline__ unsigned xb_ld(unsigned* p)              { return __hip_atomic_load(p, __ATOMIC_RELAXED, __HIP_MEMORY_SCOPE_AGENT); }
__device__ __forceinline__ unsigned xb_add(unsigned* p, unsigned v) { return __hip_atomic_fetch_add(p, v, __ATOMIC_RELAXED, __HIP_MEMORY_SCOPE_AGENT); }
__device__ __forceinline__ unsigned xb_xcc_id() { return (unsigned)__builtin_amdgcn_s_getreg((3 << 11) | 20) & 0xFu; }
#define XB_SPIN(cond, bar) do { unsigned _sp = 0; while (cond) { __builtin_amdgcn_s_sleep(1); \
    if ((++_sp & 255u) == 0u) { if (xb_ld(&(bar)[XB_TMO])) break; if (_sp > XB_SPIN_CAP) { atomicAdd(&(bar)[XB_TMO], 1u); break; } } } } while (0)
struct XcdBarrier { unsigned* bar; unsigned x; volatile LAS unsigned* st; };
__device__ __forceinline__ XcdBarrier xcd_barrier_post(unsigned* bar, volatile LAS unsigned* st) {
    XcdBarrier b; b.bar = bar; b.x = xb_xcc_id(); b.st = st;
    if (threadIdx.x == 0) (void)xb_add(&bar[XB_XCNT(b.x)], 1u);
    return b;
}
__device__ __forceinline__ void xcd_barrier_complete(unsigned* bar, unsigned x, unsigned& nloc, unsigned& nx) {
    const unsigned G = gridDim.x * gridDim.y * gridDim.z;
    unsigned sum, cnt, mine, sp = 0u;
    for (;;) {
        sum = 0u; cnt = 0u; mine = 0u;
#pragma unroll
        for (unsigned j = 0; j < 16; ++j) { const unsigned c = xb_ld(&bar[XB_XCNT(j)]); sum += c; cnt += (c > 0u) ? 1u : 0u; mine = (j == x) ? c : mine; }
        if (sum == G) break;
        __builtin_amdgcn_s_sleep(1);
        if ((++sp & 255u) == 0u) { if (xb_ld(&bar[XB_TMO])) break; if (sp > XB_SPIN_CAP) { atomicAdd(&bar[XB_TMO], 1u); break; } }
    }
    nloc = mine > 0u ? mine : 1u; nx = cnt > 0u ? cnt : 1u;
}
__device__ __forceinline__ void xcd_barrier(const XcdBarrier& b) {
    asm volatile("s_waitcnt vmcnt(0)" ::: "memory");
    __syncthreads();
    if (threadIdx.x == 0) {
        unsigned* bar = b.bar;
        __builtin_amdgcn_s_waitcnt(0);
        unsigned nloc = b.st[0], nx = b.st[1];
        if (nloc == 0u) { xcd_barrier_complete(bar, b.x, nloc, nx); b.st[0] = nloc; b.st[1] = nx; }
        const unsigned old = xb_add(&bar[XB_XSUB(b.x)], 1u);
        const unsigned gen = old / nloc;
        if (old + 1u == (gen + 1u) * nloc) {
            __builtin_amdgcn_fence(__ATOMIC_RELEASE, "agent");
            asm volatile("s_waitcnt vmcnt(0)" ::: "memory");
            const unsigned og = xb_add(&bar[XB_TOP], 1u);
            const unsigned tg = og / nx;
            if (og + 1u == (tg + 1u) * nx) xb_add(&bar[XB_TOPGEN], 1u);
            else XB_SPIN(xb_ld(&bar[XB_TOPGEN]) == tg, bar);
            __builtin_amdgcn_fence(__ATOMIC_ACQUIRE, "agent");
            xb_add(&bar[XB_XGEN(b.x)], 1u);
            asm volatile("s_waitcnt vmcnt(0)" ::: "memory");
        } else {
            XB_SPIN(xb_ld(&bar[XB_XGEN(b.x)]) == gen, bar);
            __builtin_amdgcn_fence(__ATOMIC_ACQUIRE, "agent");
            asm volatile("s_waitcnt vmcnt(0)" ::: "memory");
        }
    }
    __syncthreads();
}

constexpr int NWAVES = 8;
constexpr int RING_BYTES = 131072, LDSCTL_OFF = RING_BYTES, MISC_OFF = LDSCTL_OFF + 320, LDS_BYTES = 147456;
struct Frame { LAS unsigned char* lds; int tid, lane, wave, vcu, G; unsigned char* ws; };

DEV int colmap(int map, int c) {
    if (map == 1) { const int ct = c & 255; return (c & ~255) + 128 * ((ct >> 5) & 1) + 32 * (ct >> 6) + (ct & 31); }
    if (map == 2) return 256 * (c >> 7) + (c & 127);
    if (map == 3) return 256 * (c >> 7) + 128 + (c & 127);
    return c;
}
DEV unsigned pk2(float lo, float hi) { return (unsigned)f2bf(lo) | ((unsigned)f2bf(hi) << 16); }
DEV void p0_transpose_item(const float* W, int ldw, int N, const float* kgain, bf16_t* WT, int ldt, int koff, int map, LAS bf16_t* scr, int item, int lane) {
    const int nblk = N / 64, kb = item / nblk, nb = item % nblk, k0 = 64 * kb, n0 = 64 * nb;
    const int kr = lane >> 4, nq = (lane & 15) * 4;
    float4 v[16];
#pragma unroll
    for (int i = 0; i < 16; ++i) v[i] = *(const float4*)(W + (size_t)(k0 + 4 * i + kr) * ldw + n0 + nq);
#pragma unroll
    for (int i = 0; i < 16; ++i) { const int kk = 4 * i + kr; const float g = kgain ? kgain[k0 + kk] : 1.0f;
        scr[(nq + 0) * 72 + kk] = f2bf(v[i].x * g); scr[(nq + 1) * 72 + kk] = f2bf(v[i].y * g); scr[(nq + 2) * 72 + kk] = f2bf(v[i].z * g); scr[(nq + 3) * 72 + kk] = f2bf(v[i].w * g); }
    asm volatile("s_waitcnt lgkmcnt(0)" ::: "memory");
    const int c = lane & 7;
#pragma unroll
    for (int j = 0; j < 8; ++j) { const int n = (lane >> 3) + 8 * j; const pg8::u32x4 o = *(const LAS pg8::u32x4*)(scr + n * 72 + 8 * c);
        *(pg8::u32x4*)(WT + (size_t)colmap(map, n0 + n) * ldt + koff + k0 + 8 * c) = o; }
    asm volatile("s_waitcnt lgkmcnt(0)" ::: "memory");
}
DEV void p0_meta_proj(Frame& F, const In& in, int grp) {
    unsigned char* ws = F.ws; const int lane = F.lane, w = F.wave;
    const int col = QKW + grp * 64 + lane;
    LAS float* red = (LAS float*)F.lds;
    float acc[NMETA], ssx[NMETA];
#pragma unroll
    for (int j = 0; j < NMETA; ++j) { acc[j] = 0.f; ssx[j] = 0.f; }
    for (int kb = 0; kb < 256; kb += 16) {
        float wv[16];
#pragma unroll
        for (int i = 0; i < 16; ++i) { const int k = 256 * w + kb + i; wv[i] = in.w_in[(size_t)k * INW + col] * in.norm_mix[k]; }
#pragma unroll
        for (int i = 0; i < 16; ++i) { const int k = 256 * w + kb + i;
#pragma unroll
            for (int j = 0; j < NMETA; ++j) { const float xm = in.meta[(size_t)j * DM + k]; acc[j] += xm * wv[i]; ssx[j] += xm * xm; } }
    }
#pragma unroll
    for (int j = 0; j < NMETA; ++j) { red[(w * 17 + j) * 64 + lane] = acc[j]; }
    if (lane < NMETA) {
        float sv = 0.f;
#pragma unroll
        for (int j = 0; j < NMETA; ++j) sv = (lane == j) ? ssx[j] : sv;
        red[(w * 17 + 16) * 64 + lane] = sv;
    }
    __syncthreads();
    if (w == 0) {
#pragma unroll
        for (int j = 0; j < NMETA; ++j) {
            float a = 0.f, sq = 0.f;
#pragma unroll
            for (int ww = 0; ww < 8; ++ww) { a += red[(ww * 17 + j) * 64 + lane]; sq += red[(ww * 17 + 16) * 64 + j]; }
            const float v = a * rsqrtf(sq * (1.0f / DM) + EPS);
            const int row = T + j;
            if (grp < 16) { const float r = rsqrtf(wave_sum(v * v) * (1.0f / 64.0f) + EPS); ((bf16_t*)(ws + WS_K))[(size_t)row * QKW + grp * 64 + lane] = f2bf(v * r * in.k_norm[lane]); }
            else if (grp < 32) ((bf16_t*)(ws + WS_V))[(size_t)row * QKW + (grp - 16) * 64 + lane] = f2bf(v);
            else ((float*)(ws + WS_CTL + C_UMETA))[(size_t)j * SSMW + (grp - 32) * 64 + lane] = v;
        }
    }
    __syncthreads();
}
DEV void p0_prologue(Frame& F, const In& in) {
    unsigned char* ws = F.ws;
    for (int gq = F.vcu; gq < 48; gq += F.G) p0_meta_proj(F, in, gq);
    LAS bf16_t* scr = (LAS bf16_t*)(F.lds + F.wave * 16384);
    const int gw = F.vcu * NWAVES + F.wave, NGW = F.G * NWAVES;
    constexpr int I_IN = (DM / 64) * (INW / 64), I_GLU = (SSMW / 64) * (SSMW / 64), I_OUTH = (SSMW / 64) * (DM / 64), I_SHG = (DM / 64) * (SH / 64), I_SHD = (SH / 64) * (DM / 64);
    constexpr int I_EG = (DM / 64) * (EH / 64), I_ED = (EH / 64) * (DM / 64);
    constexpr int NITEMS = I_IN + I_GLU + 2 * I_OUTH + 2 * I_SHG + I_SHD + NE * (2 * I_EG + I_ED);
    for (int it = gw; it < NITEMS; it += NGW) {
        int r = it;
        if (r < I_IN) { p0_transpose_item(in.w_in, INW, INW, in.norm_mix, (bf16_t*)(ws + WS_WT_IN), DM, 0, 1, scr, r, F.lane); continue; } r -= I_IN;
        if (r < I_GLU) { p0_transpose_item(in.w_glu, SSMW, SSMW, nullptr, (bf16_t*)(ws + WS_WT_GLU), SSMW, 0, 0, scr, r, F.lane); continue; } r -= I_GLU;
        if (r < I_OUTH) { p0_transpose_item(in.w_out + (size_t)SSMW * DM, DM, DM, in.ssm_norm, (bf16_t*)(ws + WS_WT_OUT), DM, 0, 0, scr, r, F.lane); continue; } r -= I_OUTH;
        if (r < I_OUTH) { p0_transpose_item(in.w_out, DM, DM, nullptr, (bf16_t*)(ws + WS_WT_OUT), DM, SSMW, 0, scr, r, F.lane); continue; } r -= I_OUTH;
        if (r < I_SHG) { p0_transpose_item(in.sh_gate, SH, SH, in.norm_ffn, (bf16_t*)(ws + WS_WT_SHGU), DM, 0, 2, scr, r, F.lane); continue; } r -= I_SHG;
        if (r < I_SHG) { p0_transpose_item(in.sh_up, SH, SH, in.norm_ffn, (bf16_t*)(ws + WS_WT_SHGU), DM, 0, 3, scr, r, F.lane); continue; } r -= I_SHG;
        if (r < I_SHD) { p0_transpose_item(in.sh_down, DM, DM, nullptr, (bf16_t*)(ws + WS_WT_SHD), SH, 0, 0, scr, r, F.lane); continue; } r -= I_SHD;
        { const int per = 2 * I_EG + I_ED, e = r / per; int q = r % per;
          if (q < I_EG) { p0_transpose_item(in.w_gate + (size_t)e * DM * EH, EH, EH, in.norm_ffn, (bf16_t*)(ws + WS_WGU) + (size_t)e * 1024 * DM, DM, 0, 2, scr, q, F.lane); continue; } q -= I_EG;
          if (q < I_EG) { p0_transpose_item(in.w_up + (size_t)e * DM * EH, EH, EH, in.norm_ffn, (bf16_t*)(ws + WS_WGU) + (size_t)e * 1024 * DM, DM, 0, 3, scr, q, F.lane); continue; } q -= I_EG;
          p0_transpose_item(in.w_down + (size_t)e * EH * DM, DM, DM, nullptr, (bf16_t*)(ws + WS_WDN) + (size_t)e * DM * EH, EH, 0, 0, scr, q, F.lane); }
    }
    for (int row = gw; row < T; row += NGW) {
        const float* src = in.x + (size_t)row * DM; bf16_t* dst = (bf16_t*)(ws + WS_XB) + (size_t)row * DM; float ss = 0.f;
#pragma unroll
        for (int j = 0; j < DM / 256; ++j) { const float4 v = *(const float4*)(src + j * 256 + F.lane * 4); ss += v.x * v.x + v.y * v.y + v.z * v.z + v.w * v.w;
            uint2 o; o.x = pk2(v.x, v.y); o.y = pk2(v.z, v.w); *(uint2*)(dst + j * 256 + F.lane * 4) = o; }
        ss = wave_sum(ss); if (F.lane == 0) ((float*)(ws + WS_CTL + C_RSTDX))[row] = rsqrtf(ss * (1.0f / DM) + EPS);
    }
    {
        const int tid = gw * 64 + F.lane, nthr = NGW * 64;
        float* lut = (float*)(ws + WS_CTL + C_LUT);
        for (int i = tid; i < NH * LUTN; i += nthr) { const int h = i / LUTN, rel = i % LUTN - 91; lut[i] = in.rel_bias[t5_bucket(rel) * NH + h] * LOG2E; }
        if (tid == 0) { float s1 = 0.f, s2 = 0.f; for (int i = 0; i < HD; ++i) { s1 += in.lam_q1[i] * in.lam_k1[i]; s2 += in.lam_q2[i] * in.lam_k2[i]; } *(float*)(ws + WS_CTL + C_LAM) = expf(s1) - expf(s2) + 0.2f; }
        float* abar = (float*)(ws + WS_CTL + C_SSMP); float* bbar = abar + 2 * 64 * 64 * 2;
        for (int i = tid; i < 2 * NG * NST; i += nthr) {
            const int dg = i / NST; const float are = in.a_re[i], aim = in.a_im[i], dt = expf(in.log_step[dg]);
            const float decay = expf(are * dt); float sn, cs; sincosf(aim * dt, &sn, &cs);
            const float abr = decay * cs, abi = decay * sn, den = are * are + aim * aim, zr = abr - 1.0f;
            const float fre = (zr * are + abi * aim) / den, fim = (abi * are - zr * aim) / den;
            abar[i * 2] = abr; abar[i * 2 + 1] = abi;
            for (int p = 0; p < GP; ++p) { const float br = in.b_re[(size_t)i * GP + p], bi = in.b_im[(size_t)i * GP + p];
                bbar[((size_t)i * GP + p) * 2] = fre * br - fim * bi; bbar[((size_t)i * GP + p) * 2 + 1] = fre * bi + fim * br; }
        }
        bf16_t* Kb = (bf16_t*)(ws + WS_K); bf16_t* Vb = (bf16_t*)(ws + WS_V);
        for (int i = tid; i < (KROWS - LTOT) * QKW; i += nthr) { Kb[(size_t)LTOT * QKW + i] = 0; Vb[(size_t)LTOT * QKW + i] = 0; }
        float* WR = (float*)(ws + WS_WR);
        for (int i = tid; i < DM * NE; i += nthr) WR[i] = in.norm_ffn[i >> 6] * in.router_w[i];
    }
}

struct EpiInProjF {
    static constexpr int MIDK_T = 0;
    unsigned char* ws; const float* qn; const float* kn;
    __device__ __forceinline__ void midk(pg8::f32x4 (&)[2][2][4][2], const pg8::Unit&, int, int, int, int) const {}
    __device__ __forceinline__ void operator()(const pg8::f32x4 (&acc)[2][2][4][2], const pg8::Unit& u, int wr, int wc, int fr, int fq) const {
        using namespace pg8;
        const int kind = u.pn >> 2;
        const int row0 = u.pm * BM + wr * 64 + fr;
        const int ct0 = (u.pn & 3) * 256 + 64 * wc + 8 * fq;
        const float* rstd = (const float*)(ws + WS_CTL + C_RSTDX);
        float gn[2][8];
        if (kind < 2) { const float* gsrc = kind == 0 ? qn : kn;
#pragma unroll
            for (int bj = 0; bj < 2; ++bj)
#pragma unroll
                for (int j = 0; j < 8; ++j) gn[bj][j] = gsrc[32 * bj + 8 * fq + j] * (kind == 0 ? C2 : 1.0f); }
#pragma unroll
        for (int ai = 0; ai < 2; ++ai)
#pragma unroll
            for (int m = 0; m < 4; ++m) {
                const int row = row0 + ai * HALF + m * 16; const float rs = rstd[row];
                f32x4 v[2][2]; float ss = 0.f;
#pragma unroll
                for (int bj = 0; bj < 2; ++bj)
#pragma unroll
                    for (int n = 0; n < 2; ++n) { v[bj][n] = acc[ai][bj][m][n] * rs; ss += (v[bj][n][0] * v[bj][n][0] + v[bj][n][1] * v[bj][n][1]) + (v[bj][n][2] * v[bj][n][2] + v[bj][n][3] * v[bj][n][3]); }
                if (kind < 2) { ss += __shfl_xor(ss, 16); ss += __shfl_xor(ss, 32); const float r = rsqrtf(ss * (1.0f / 64.0f) + EPS);
#pragma unroll
                    for (int bj = 0; bj < 2; ++bj)
#pragma unroll
                        for (int n = 0; n < 2; ++n)
#pragma unroll
                            for (int j = 0; j < 4; ++j) v[bj][n][j] *= r * gn[bj][4 * n + j]; }
#pragma unroll
                for (int bj = 0; bj < 2; ++bj) {
                    u32x4 w; w.x = cvt_pk_bf16(v[bj][0][0], v[bj][0][1]); w.y = cvt_pk_bf16(v[bj][0][2], v[bj][0][3]); w.z = cvt_pk_bf16(v[bj][1][0], v[bj][1][1]); w.w = cvt_pk_bf16(v[bj][1][2], v[bj][1][3]);
                    const int cc = ct0 + 32 * bj;
                    if (kind == 0) *(u32x4*)((bf16_t*)(ws + WS_Q) + (size_t)row * QKW + cc) = w;
                    else if (kind == 1) *(u32x4*)((bf16_t*)(ws + WS_K) + (size_t)row * QKW + cc) = w;
                    else if (kind == 2) *(u32x4*)((bf16_t*)(ws + WS_V) + (size_t)row * QKW + cc) = w;
                    else *(u32x4*)((bf16_t*)(ws + WS_UX) + ((size_t)(cc >> 4) * NCH + (row >> 5)) * 768 + (row & 31) * 16 + (cc & 15)) = w;
                }
            }
    }
};

constexpr size_t WS_S    = WS_H;
constexpr size_t WS_MTAB = WS_H + 64 * MiB;
constexpr size_t TG_BYTES = (size_t)512 * 768 * 2, EST_OFF = TG_BYTES;
DEV void ssm_disc(const In& in, int dg, int n, float& abr, float& abi, float& fre, float& fim) {
    const int i = dg * NST + n; const float are = in.a_re[i], aim = in.a_im[i], dt = expf(in.log_step[dg]);
    const float decay = expf(are * dt); float sn, cs; sincosf(aim * dt, &sn, &cs);
    abr = decay * cs; abi = decay * sn; const float den = are * are + aim * aim, zr = abr - 1.0f;
    fre = (zr * are + abi * aim) / den; fim = (abi * are - zr * aim) / den;
}
DEV void p0_ssm_tables(Frame& F, const In& in) {
    unsigned char* ws = F.ws;
    const int tid = (F.vcu * NWAVES + F.wave) * 64 + F.lane, nthr = F.G * NWAVES * 64;
    float* Mtab = (float*)(ws + WS_MTAB);
    for (int t = tid; t < NG * 2 * 256; t += nthr) {
        const int q = t & 15, p = (t >> 4) & 15, dir = (t >> 8) & 1, g = t >> 9, dg = dir * NG + g;
        float M[32];
#pragma unroll
        for (int d = 0; d < 32; ++d) M[d] = 0.f;
        for (int n = 0; n < NST; ++n) {
            float abr, abi, fre, fim; ssm_disc(in, dg, n, abr, abi, fre, fim);
            const size_t bi = ((size_t)dg * NST + n) * GP + q, ci = ((size_t)dg * GP + p) * NST + n;
            const float br = in.b_re[bi], bim = in.b_im[bi], bbr = fre * br - fim * bim, bbi = fre * bim + fim * br;
            const float cr = in.c_re[ci], cim = in.c_im[ci];
            float zr = cr * bbr - cim * bbi, zi = cr * bbi + cim * bbr;
#pragma unroll
            for (int d = 0; d < 32; ++d) { M[d] += zr; const float nr = zr * abr - zi * abi, ni = zr * abi + zi * abr; zr = nr; zi = ni; }
        }
#pragma unroll
        for (int d = 0; d < 32; ++d) Mtab[(((size_t)g * 2 + dir) * 32 + d) * 256 + p * 16 + q] = M[d];
    }
    for (int t = tid; t < NG * 2 * NST * GP; t += nthr) {
        const int q = t & 15, n = (t >> 4) & 63, dir = (t >> 10) & 1, g = t >> 11, dg = dir * NG + g;
        float abr, abi, fre, fim; ssm_disc(in, dg, n, abr, abi, fre, fim);
        const size_t bi = ((size_t)dg * NST + n) * GP + q; const float br = in.b_re[bi], bim = in.b_im[bi];
        float zr = fre * br - fim * bim, zi = fre * bim + fim * br;
        bf16_t* Est = (bf16_t*)(ws + WS_TAB + (size_t)g * MiB + EST_OFF);
        for (int d = 0; d < TC; ++d) {
            const int j = dir ? d : TC - 1 - d;
            Est[(size_t)(dir * 128 + n) * 512 + j * 16 + q] = f2bf(zr); Est[(size_t)(dir * 128 + 64 + n) * 512 + j * 16 + q] = f2bf(zi);
            const float nr = zr * abr - zi * abi, ni = zr * abi + zi * abr; zr = nr; zi = ni;
        }
    }
    for (int t = tid; t < NG * 2 * GP * NST; t += nthr) {
        const int n = t & 63, p = (t >> 6) & 15, dir = (t >> 10) & 1, g = t >> 11, dg = dir * NG + g;
        float abr, abi, fre, fim; ssm_disc(in, dg, n, abr, abi, fre, fim);
        const size_t ci = ((size_t)dg * GP + p) * NST + n; const float cr = in.c_re[ci], cim = in.c_im[ci];
        float zr = cr * abr - cim * abi, zi = cr * abi + cim * abr;
        bf16_t* TG = (bf16_t*)(ws + WS_TAB + (size_t)g * MiB);
        for (int k = 1; k <= TC; ++k) {
            const int i = dir ? TC - k : k - 1;
            TG[(size_t)(i * 16 + p) * 768 + 512 + dir * 128 + n] = f2bf(zr); TG[(size_t)(i * 16 + p) * 768 + 512 + dir * 128 + 64 + n] = f2bf(-zi);
            const float nr = zr * abr - zi * abi, ni = zr * abi + zi * abr; zr = nr; zi = ni;
        }
    }
}
DEV void p4_scan(Frame& F, const In& in, int idx) {
    unsigned char* ws = F.ws;
    const int n = idx & 63, dir = (idx >> 6) & 1, g = idx >> 7, dg = dir * NG + g;
    float abr, abi, fre, fim; ssm_disc(in, dg, n, abr, abi, fre, fim);
    float xr = 0.f, xi = 0.f;
    if (dir == 0) {
        float br[GP], bi[GP];
#pragma unroll
        for (int q = 0; q < GP; ++q) { const size_t bx = ((size_t)dg * NST + n) * GP + q; const float b0 = in.b_re[bx], b1 = in.b_im[bx]; br[q] = fre * b0 - fim * b1; bi[q] = fre * b1 + fim * b0; }
        const float* um = (const float*)(ws + WS_CTL + C_UMETA);
        for (int j = 0; j < NMETA; ++j) { float bur = 0.f, bui = 0.f;
#pragma unroll
            for (int q = 0; q < GP; ++q) { const float u = um[(size_t)j * SSMW + g * GP + q]; bur += br[q] * u; bui += bi[q] * u; }
            const float nr = abr * xr - abi * xi + bur, ni = abr * xi + abi * xr + bui; xr = nr; xi = ni; }
    }
    float pr = abr, pi = abi;
#pragma unroll
    for (int k = 0; k < 5; ++k) { const float nr = pr * pr - pi * pi, ni = 2.0f * pr * pi; pr = nr; pi = ni; }
    const float* S = (const float*)(ws + WS_S) + (size_t)g * NCH * 256 + dir * 128 + n;
    bf16_t* X = (bf16_t*)(ws + WS_UX) + (size_t)g * NCH * 768 + 512 + dir * 128 + n;
    for (int c0 = 0; c0 < NCH; c0 += 8) {
        float sr[8], si[8];
#pragma unroll
        for (int k = 0; k < 8; ++k) { const int c = dir ? NCH - 1 - (c0 + k) : c0 + k; sr[k] = S[(size_t)c * 256]; si[k] = S[(size_t)c * 256 + 64]; }
#pragma unroll
        for (int k = 0; k < 8; ++k) { const int c = dir ? NCH - 1 - (c0 + k) : c0 + k;
            X[(size_t)c * 768] = f2bf(xr); X[(size_t)c * 768 + 64] = f2bf(xi);
            const float nr = pr * xr - pi * xi + sr[k], ni = pr * xi + pi * xr + si[k]; xr = nr; xi = ni; }
    }
}
DEV void p4_expand(Frame& F, const In& in, int worker, int nworkers) {
    unsigned char* ws = F.ws;
    const float* Mtab = (const float*)(ws + WS_MTAB);
    for (int it = worker; it < NG * 512 * 64; it += nworkers) {
        const int kc = it & 63, row = (it >> 6) & 511, g = it >> 15;
        const int j = kc >> 1, q0 = (kc & 1) * 8, i = row >> 4, p = row & 15;
        float v[8];
#pragma unroll
        for (int e = 0; e < 8; ++e) v[e] = 0.f;
        if (j <= i) { const float* m = Mtab + (((size_t)g * 2 + 0) * 32 + (i - j)) * 256 + p * 16 + q0;
#pragma unroll
            for (int e = 0; e < 8; ++e) v[e] += m[e]; }
        if (j >= i) { const float* m = Mtab + (((size_t)g * 2 + 1) * 32 + (j - i)) * 256 + p * 16 + q0;
#pragma unroll
            for (int e = 0; e < 8; ++e) v[e] += m[e]; }
        if (i == j) {
#pragma unroll
            for (int e = 0; e < 8; ++e) if (q0 + e == p) v[e] += in.ssm_d[g * GP + p]; }
        uint4 o; o.x = pk2(v[0], v[1]); o.y = pk2(v[2], v[3]); o.z = pk2(v[4], v[5]); o.w = pk2(v[6], v[7]);
        *(uint4*)((bf16_t*)(ws + WS_TAB + (size_t)g * MiB) + (size_t)row * 768 + j * 16 + q0) = o;
    }
}
struct SsmOrder {
    const char* A; const char* B; size_t bgstride, bnstride; int npm, npn, G, vcu;
    __device__ __forceinline__ bool next(int i, pg8::Unit& u) const {
        const int L = i * G + vcu; if (L >= NG * npm * npn) return false;
        const int pn = L % npn, pm = (L / npn) % npm, g = L / (npn * npm);
        u.pm = pm; u.pn = pn; u.e = g; u.slot0 = 0;
        u.A = A + ((size_t)g * NCH + (size_t)pm * 256) * 768 * 2; u.B = B + (size_t)g * bgstride + (size_t)pn * bnstride; return true;
    }
};
struct EpiSsmS {
    static constexpr int MIDK_T = 0;
    unsigned char* ws;
    __device__ __forceinline__ void midk(pg8::f32x4 (&)[2][2][4][2], const pg8::Unit&, int, int, int, int) const {}
    __device__ __forceinline__ void operator()(const pg8::f32x4 (&acc)[2][2][4][2], const pg8::Unit& u, int wr, int wc, int fr, int fq) const {
        using namespace pg8;
        float* S = (float*)(ws + WS_S) + (size_t)u.e * NCH * 256;
#pragma unroll
        for (int ai = 0; ai < 2; ++ai)
#pragma unroll
            for (int m = 0; m < 4; ++m) { const int c = u.pm * BM + ai * HALF + wr * 64 + m * 16 + fr;
#pragma unroll
                for (int bj = 0; bj < 2; ++bj) { float* o = S + (size_t)c * 256 + bj * HALF + wc * 32 + fq * 8; *(f32x4*)o = acc[ai][bj][m][0]; *(f32x4*)(o + 4) = acc[ai][bj][m][1]; } }
    }
};
struct EpiSsmY {
    static constexpr int MIDK_T = 0;
    unsigned char* ws;
    __device__ __forceinline__ void midk(pg8::f32x4 (&)[2][2][4][2], const pg8::Unit&, int, int, int, int) const {}
    __device__ __forceinline__ void operator()(const pg8::f32x4 (&acc)[2][2][4][2], const pg8::Unit& u, int wr, int wc, int fr, int fq) const {
        using namespace pg8;
        bf16_t* YS = (bf16_t*)(ws + WS_YS);
#pragma unroll
        for (int ai = 0; ai < 2; ++ai)
#pragma unroll
            for (int m = 0; m < 4; ++m) { const int c = u.pm * BM + ai * HALF + wr * 64 + m * 16 + fr;
#pragma unroll
                for (int bj = 0; bj < 2; ++bj) {
                    const int cc = u.pn * 256 + bj * HALF + wc * 32 + fq * 8, i = cc >> 4, p0 = cc & 15;
                    float y[8];
#pragma unroll
                    for (int n = 0; n < 2; ++n)
#pragma unroll
                        for (int jx = 0; jx < 4; ++jx) { const float x = acc[ai][bj][m][n][jx]; const float t2 = 2.0f * 0.7978845608028654f * (x + 0.044715f * x * x * x);
                            y[4 * n + jx] = x * __builtin_amdgcn_rcpf(1.0f + __builtin_amdgcn_exp2f(-t2 * LOG2E)); }
                    u32x4 w; w.x = cvt_pk_bf16(y[0], y[1]); w.y = cvt_pk_bf16(y[2], y[3]); w.z = cvt_pk_bf16(y[4], y[5]); w.w = cvt_pk_bf16(y[6], y[7]);
                    *(u32x4*)(YS + (size_t)(32 * c + i) * SSMW + u.e * GP + p0) = w;
                } }
    }
};

struct EpiGluF {
    static constexpr int MIDK_T = 0;
    unsigned char* ws; const float* bglu;
    __device__ __forceinline__ void midk(pg8::f32x4 (&)[2][2][4][2], const pg8::Unit&, int, int, int, int) const {}
    __device__ __forceinline__ void operator()(const pg8::f32x4 (&acc)[2][2][4][2], const pg8::Unit& u, int wr, int wc, int fr, int fq) const {
        using namespace pg8;
        const bf16_t* YS = (const bf16_t*)(ws + WS_YS); bf16_t* CAT = (bf16_t*)(ws + WS_CAT); float* SSQ = (float*)(ws + WS_SSQ);
        const int col0 = u.pn * 256 + wc * 32 + fq * 8;
        f32x4 bv[2][2];
#pragma unroll
        for (int bj = 0; bj < 2; ++bj)
#pragma unroll
            for (int n = 0; n < 2; ++n) bv[bj][n] = *(const f32x4*)(bglu + col0 + bj * HALF + 4 * n);
#pragma unroll
        for (int ai = 0; ai < 2; ++ai)
#pragma unroll
            for (int m = 0; m < 4; ++m) {
                const int row = u.pm * BM + ai * HALF + wr * 64 + m * 16 + fr; float ss = 0.f;
#pragma unroll
                for (int bj = 0; bj < 2; ++bj) {
                    const u32x4 yv = *(const u32x4*)(YS + (size_t)row * SSMW + col0 + bj * HALF);
                    const float y[8] = {__uint_as_float(yv.x << 16), __uint_as_float(yv.x & 0xffff0000u), __uint_as_float(yv.y << 16), __uint_as_float(yv.y & 0xffff0000u),
                                        __uint_as_float(yv.z << 16), __uint_as_float(yv.z & 0xffff0000u), __uint_as_float(yv.w << 16), __uint_as_float(yv.w & 0xffff0000u)};
                    float so[8];
#pragma unroll
                    for (int n = 0; n < 2; ++n)
#pragma unroll
                        for (int jx = 0; jx < 4; ++jx) { const float z = acc[ai][bj][m][n][jx] + bv[bj][n][jx]; so[4 * n + jx] = y[4 * n + jx] * __builtin_amdgcn_rcpf(1.0f + __builtin_amdgcn_exp2f(-z * LOG2E)); ss += so[4 * n + jx] * so[4 * n + jx]; }
                    u32x4 w; w.x = cvt_pk_bf16(so[0], so[1]); w.y = cvt_pk_bf16(so[2], so[3]); w.z = cvt_pk_bf16(so[4], so[5]); w.w = cvt_pk_bf16(so[6], so[7]);
                    *(u32x4*)(CAT + (size_t)row * DM + col0 + bj * HALF) = w;
                }
                ss += __shfl_xor(ss, 16); ss += __shfl_xor(ss, 32);
                if (fq == 0) SSQ[(size_t)row * 16 + u.pn * 4 + wc] = ss;
            }
    }
};
struct EpiOutF {
    static constexpr int MIDK_T = 16;
    unsigned char* ws; const float* x;
    __device__ __forceinline__ void midk(pg8::f32x4 (&acc)[2][2][4][2], const pg8::Unit& u, int wr, int wc, int fr, int fq) const {
        using namespace pg8;
        const float* SSQ = (const float*)(ws + WS_SSQ);
#pragma unroll
        for (int ai = 0; ai < 2; ++ai)
#pragma unroll
            for (int m = 0; m < 4; ++m) {
                const int row = u.pm * BM + ai * HALF + wr * 64 + m * 16 + fr;
                const f32x4 a = *(const f32x4*)(SSQ + (size_t)row * 16), b = *(const f32x4*)(SSQ + (size_t)row * 16 + 4), c = *(const f32x4*)(SSQ + (size_t)row * 16 + 8), d = *(const f32x4*)(SSQ + (size_t)row * 16 + 12);
                const float ss = (((a[0] + a[1]) + (a[2] + a[3])) + ((b[0] + b[1]) + (b[2] + b[3]))) + (((c[0] + c[1]) + (c[2] + c[3])) + ((d[0] + d[1]) + (d[2] + d[3])));
                const float rs = rsqrtf(ss * (1.0f / SSMW) + EPS);
#pragma unroll
                for (int bj = 0; bj < 2; ++bj)
#pragma unroll
                    for (int n = 0; n < 2; ++n) acc[ai][bj][m][n] = acc[ai][bj][m][n] * rs;
            }
    }
    __device__ __forceinline__ void operator()(const pg8::f32x4 (&acc)[2][2][4][2], const pg8::Unit& u, int wr, int wc, int fr, int fq) const {
        using namespace pg8;
        float* H = (float*)(ws + WS_H); bf16_t* HB = (bf16_t*)(ws + WS_HB);
        const int col0 = u.pn * 256 + wc * 32 + fq * 8;
#pragma unroll
        for (int ai = 0; ai < 2; ++ai)
#pragma unroll
            for (int m = 0; m < 4; ++m) {
                const int row = u.pm * BM + ai * HALF + wr * 64 + m * 16 + fr;
#pragma unroll
                for (int bj = 0; bj < 2; ++bj) {
                    const size_t o = (size_t)row * DM + col0 + bj * HALF;
                    const f32x4 v0 = acc[ai][bj][m][0] + *(const f32x4*)(x + o), v1 = acc[ai][bj][m][1] + *(const f32x4*)(x + o + 4);
                    *(f32x4*)(H + o) = v0; *(f32x4*)(H + o + 4) = v1;
                    u32x4 w; w.x = cvt_pk_bf16(v0[0], v0[1]); w.y = cvt_pk_bf16(v0[2], v0[3]); w.z = cvt_pk_bf16(v1[0], v1[1]); w.w = cvt_pk_bf16(v1[2], v1[3]);
                    *(u32x4*)(HB + o) = w;
                }
            }
    }
};
DEV int route_token(const In& in, unsigned char* ws, int t, int lane, float logit, LAS int* lcnt) {
    const float score = sigmoidf_(logit);
    const float choice = score + in.router_bias[lane];
    float m1 = choice;
#pragma unroll
    for (int o = 1; o < 8; o <<= 1) m1 = fmaxf(m1, __shfl_xor(m1, o));
    const unsigned long long b1 = __ballot(choice == m1); const int gbase = lane & ~7;
    const unsigned gb = (unsigned)((b1 >> gbase) & 0xffull); const int first = gbase + __builtin_ctz(gb | 0x100u);
    float m2 = (lane == first) ? -INFINITY : choice;
#pragma unroll
    for (int o = 1; o < 8; o <<= 1) m2 = fmaxf(m2, __shfl_xor(m2, o));
    const float gs = m1 + m2;
    int grank = 0; const int myg = lane >> 3;
#pragma unroll
    for (int j = 0; j < 8; ++j) { const float o = __shfl(gs, j * 8); grank += (o > gs || (o == gs && j < myg)) ? 1 : 0; }
    const float mv = grank < 4 ? choice : -INFINITY;
    int rank = 0;
#pragma unroll 16
    for (int j = 0; j < 64; ++j) { const float o = __builtin_bit_cast(float, __builtin_amdgcn_readlane(__builtin_bit_cast(int, mv), j)); rank += (o > mv || (o == mv && j < lane)) ? 1 : 0; }
    const bool sel = rank < TOPK;
    const float ssum = wave_sum(sel ? score : 0.f);
    int ret = -1;
    if (sel) {
        const int lpos = __hip_atomic_fetch_add(lcnt + lane, 1, __ATOMIC_RELAXED, __HIP_MEMORY_SCOPE_WORKGROUP);
        ((int*)(ws + WS_CTL + C_IDX))[t * TOPK + rank] = lane;
        ((float*)(ws + WS_CTL + C_WTS))[t * TOPK + rank] = score / ssum * 2.5f;
        ret = (rank << 16) | lpos;
    }
    return ret;
}
DEV void p8_router(Frame& F, const In& in) {
    unsigned char* ws = F.ws;
    typedef float f32x4v __attribute__((ext_vector_type(4)));
    const float* H = (const float*)(ws + WS_H); const float* WR = (const float*)(ws + WS_WR);
    const int lane = F.lane, ti = lane & 15, kq = lane >> 4, tg = F.wave & 3, kh = F.wave >> 2;
    LAS float* lg = (LAS float*)(F.lds + tg * 8192);
    LAS float* sq = (LAS float*)(F.lds + 32768 + tg * 128);
    LAS int* lcnt = (LAS int*)(F.lds + 33280); LAS int* gbs = (LAS int*)(F.lds + 33536);
    for (int blk = F.vcu; blk < T / 64; blk += F.G) {
        const int t0 = blk * 64 + tg * 16;
        f32x4v acc[4]; acc[0] = (f32x4v){0.f, 0.f, 0.f, 0.f}; acc[1] = acc[0]; acc[2] = acc[0]; acc[3] = acc[0];
        float ssq = 0.f;
        const float* hrow = H + (size_t)(t0 + ti) * DM + kh * (DM / 2) + 4 * kq;
        const float* wcol = WR + (size_t)(kh * (DM / 2) + 4 * kq) * NE + ti;
        f32x4v hA, hB, hC, hD; float bA[4][4], bB[4][4], bC[4][4], bD[4][4];
#define RT_LOAD(hv, b, g) do { hv = *(const f32x4v*)(hrow + 16 * (g)); _Pragma("unroll") for (int jx = 0; jx < 4; ++jx) _Pragma("unroll") for (int n = 0; n < 4; ++n) b[jx][n] = wcol[(size_t)(16 * (g) + jx) * NE + 16 * n]; } while (0)
#define RT_MMA(hv, b) do { ssq += (hv[0] * hv[0] + hv[1] * hv[1]) + (hv[2] * hv[2] + hv[3] * hv[3]); _Pragma("unroll") for (int jx = 0; jx < 4; ++jx) _Pragma("unroll") for (int n = 0; n < 4; ++n) acc[n] = __builtin_amdgcn_mfma_f32_16x16x4f32(hv[jx], b[jx][n], acc[n], 0, 0, 0); } while (0)
        constexpr int NGRP = DM / 32;
        RT_LOAD(hA, bA, 0); RT_LOAD(hB, bB, 1); RT_LOAD(hC, bC, 2);
        for (int g = 0; g < NGRP; g += 4) {
            RT_LOAD(hD, bD, g + 3);
            RT_MMA(hA, bA); if (g + 4 < NGRP) RT_LOAD(hA, bA, g + 4);
            RT_MMA(hB, bB); if (g + 5 < NGRP) RT_LOAD(hB, bB, g + 5);
            RT_MMA(hC, bC); if (g + 6 < NGRP) RT_LOAD(hC, bC, g + 6);
            RT_MMA(hD, bD);
        }
#undef RT_LOAD
#undef RT_MMA
        ssq += __shfl_xor(ssq, 16); ssq += __shfl_xor(ssq, 32);
        if (kq == 0) sq[kh * 16 + ti] = ssq;
#pragma unroll
        for (int r = 0; r < 4; ++r)
#pragma unroll
            for (int n = 0; n < 4; ++n) lg[(kh * 16 + 4 * kq + r) * 64 + 16 * n + ti] = acc[n][r];
        if (F.tid < NE) lcnt[F.tid] = 0;
        __syncthreads();
        int rr[8];
#pragma unroll
        for (int r = 0; r < 8; ++r) {
            const int tt = kh * 8 + r;
            const float rs = rsqrtf((sq[tt] + sq[16 + tt]) * (1.0f / DM) + EPS);
            if (lane == 0) ((float*)(ws + WS_CTL + C_RSTDH))[t0 + tt] = rs;
            rr[r] = route_token(in, ws, t0 + tt, lane, (lg[tt * 64 + lane] + lg[(16 + tt) * 64 + lane]) * rs, lcnt);
        }
        __syncthreads();
        if (F.wave == 0) { const int c = lcnt[lane]; gbs[lane] = c ? atomicAdd((int*)(ws + WS_CTL + C_CNT) + lane, c) : 0; }
        __syncthreads();
        { const int gb = gbs[lane];
#pragma unroll
          for (int r = 0; r < 8; ++r) if (rr[r] >= 0) ((int*)(ws + WS_CTL + C_POS))[(t0 + kh * 8 + r) * TOPK + (rr[r] >> 16)] = gb + (rr[r] & 0xffff); }
        __syncthreads();
    }
}
DEV void p9_scatter(Frame& F) {
    unsigned char* ws = F.ws;
    LAS int* offl = (LAS int*)F.lds;
    if (F.wave == 0) {
        const int c = __hip_atomic_load((const int*)(ws + WS_CTL + C_CNT) + F.lane, __ATOMIC_RELAXED, __HIP_MEMORY_SCOPE_AGENT);
        const int pc = (c + 255) & ~255; int incl = pc;
#pragma unroll
        for (int o = 1; o < 64; o <<= 1) { const int v = __shfl_up(incl, o); if (F.lane >= o) incl += v; }
        offl[F.lane] = incl - pc; offl[128 + F.lane] = c; if (F.lane == 63) offl[NE] = incl;
    }
    __syncthreads();
    const int tid = F.vcu * NWAVES * 64 + F.tid, nthr = F.G * NWAVES * 64;
    int* stok = (int*)(ws + WS_CTL + C_STOK); int* sdst = (int*)(ws + WS_CTL + C_SDST); float* sw = (float*)(ws + WS_CTL + C_SW);
    if (tid <= NE) ((int*)(ws + WS_CTL + C_OFF))[tid] = offl[tid];
    for (int i = tid; i < NSLOT; i += nthr) {
        int lo = 0, hi = NE;
        while (hi - lo > 1) { const int mid = (lo + hi) >> 1; if (offl[mid] <= i) lo = mid; else hi = mid; }
        const bool real = (i < offl[NE]) && (i - offl[lo] < offl[128 + lo]);
        if (!real) { stok[i] = 0; sdst[i] = -1; sw[i] = 0.f; }
    }
    for (int i = tid; i < T; i += nthr) stok[NSLOT + i] = i;
    for (int i = tid; i < T * TOPK; i += nthr) {
        const int e = ((const int*)(ws + WS_CTL + C_IDX))[i]; const int slot = offl[e] + ((const int*)(ws + WS_CTL + C_POS))[i];
        stok[slot] = i >> 3; sdst[slot] = i; sw[slot] = ((const float*)(ws + WS_CTL + C_WTS))[i];
    }
}

struct MoeOrder {
    const int* cnt; const int* off; const char* A; const char* B; const char* Bsh; size_t bstride_e, bstride_pn, astride_row; int npn, ngrp, gsz, x, j, gather;
    int n0, n1, n2, n3, n4, n5, n6, n7, o0, o1, o2, o3, o4, o5, o6, o7;
    __device__ __forceinline__ static int ld_agent(const int* p) { return __builtin_amdgcn_readfirstlane(__hip_atomic_load(p, __ATOMIC_RELAXED, __HIP_MEMORY_SCOPE_AGENT)); }
    __device__ __forceinline__ void init(const int* cnt_, const int* off_, const void* A_, size_t astride_row_, const void* B_, size_t bstride_e_, const void* Bsh_, size_t bstride_pn_, int npn_, int G, int vcu, int gather_) {
        cnt = cnt_; off = off_; A = (const char*)A_; B = (const char*)B_; Bsh = (const char*)Bsh_; bstride_e = bstride_e_; bstride_pn = bstride_pn_; astride_row = astride_row_; npn = npn_; gather = gather_;
        ngrp = (G % 8 == 0) ? 8 : 1; gsz = G / ngrp; x = vcu / gsz; j = vcu % gsz;
        n0 = n1 = n2 = n3 = n4 = n5 = n6 = n7 = 0; o0 = o1 = o2 = o3 = o4 = o5 = o6 = o7 = 0;
        if (ngrp == 8) {
#define MO_LD(k) n##k = ((ld_agent(cnt + x + 8 * k) + 255) >> 8) * npn; o##k = ld_agent(off + x + 8 * k);
            MO_LD(0) MO_LD(1) MO_LD(2) MO_LD(3) MO_LD(4) MO_LD(5) MO_LD(6) MO_LD(7)
#undef MO_LD
        }
    }
    __device__ __forceinline__ void fill(pg8::Unit& u, int e, int L, int ofs) const {
        const int mt = L / npn, pn = L % npn; u.e = e; u.pm = mt; u.pn = pn; u.slot0 = ofs + mt * 256;
        u.A = gather ? A : A + (size_t)u.slot0 * astride_row; u.B = B + (size_t)e * bstride_e + (size_t)pn * bstride_pn;
    }
    __device__ __forceinline__ bool next(int i, pg8::Unit& u) const {
        int L = i * gsz + j;
        if (ngrp == 8) {
#define MO_TRY(k) if (L < n##k) { fill(u, x + 8 * k, L, o##k); return true; } L -= n##k;
            MO_TRY(0) MO_TRY(1) MO_TRY(2) MO_TRY(3) MO_TRY(4) MO_TRY(5) MO_TRY(6) MO_TRY(7)
#undef MO_TRY
        } else {
            for (int e = 0; e < NE; ++e) { const int nu = ((ld_agent(cnt + e) + 255) >> 8) * npn; if (L < nu) { fill(u, e, L, ld_agent(off + e)); return true; } L -= nu; }
        }
        if (Bsh) {
            const int mtg = (T / 256) / ngrp, nu = mtg * npn;
            if (L < nu) { const int mt = x * mtg + L / npn, pn = L % npn; u.e = NE; u.pm = mt; u.pn = pn; u.slot0 = NSLOT + mt * 256; u.A = A; u.B = Bsh + (size_t)pn * bstride_pn; return true; }
        }
        return false;
    }
};
struct EpiGateUpF {
    static constexpr int MIDK_T = 0;
    unsigned char* ws;
    __device__ __forceinline__ void midk(pg8::f32x4 (&)[2][2][4][2], const pg8::Unit&, int, int, int, int) const {}
    __device__ __forceinline__ void operator()(const pg8::f32x4 (&acc)[2][2][4][2], const pg8::Unit& u, int wr, int wc, int fr, int fq) const {
        using namespace pg8;
        const int* stok = (const int*)(ws + WS_CTL + C_STOK); const float* rstd = (const float*)(ws + WS_CTL + C_RSTDH);
        const bool sh = u.e == NE;
        bf16_t* O = sh ? (bf16_t*)(ws + WS_HS) : (bf16_t*)(ws + WS_H1);
        const int col = u.pn * 128 + wc * 32 + fq * 8;
#pragma unroll
        for (int ai = 0; ai < 2; ++ai)
#pragma unroll
            for (int m = 0; m < 4; ++m) {
                const int slot = u.slot0 + ai * HALF + wr * 64 + m * 16 + fr;
                const int tok = stok[slot]; const float rs = rstd[tok];
                const size_t orow = sh ? (size_t)tok : (size_t)slot;
                float hh[8];
#pragma unroll
                for (int n = 0; n < 2; ++n)
#pragma unroll
                    for (int jx = 0; jx < 4; ++jx) { const float g = acc[ai][0][m][n][jx] * rs, up = acc[ai][1][m][n][jx] * rs; hh[4 * n + jx] = g * up * __builtin_amdgcn_rcpf(1.0f + __builtin_amdgcn_exp2f(-g * LOG2E)); }
                u32x4 w; w.x = cvt_pk_bf16(hh[0], hh[1]); w.y = cvt_pk_bf16(hh[2], hh[3]); w.z = cvt_pk_bf16(hh[4], hh[5]); w.w = cvt_pk_bf16(hh[6], hh[7]);
                *(u32x4*)(O + orow * EH + col) = w;
            }
    }
};
struct EpiDownF {
    static constexpr int MIDK_T = 0;
    unsigned char* ws;
    __device__ __forceinline__ void midk(pg8::f32x4 (&)[2][2][4][2], const pg8::Unit&, int, int, int, int) const {}
    __device__ __forceinline__ void operator()(const pg8::f32x4 (&acc)[2][2][4][2], const pg8::Unit& u, int wr, int wc, int fr, int fq) const {
        using namespace pg8;
        const int* sdst = (const int*)(ws + WS_CTL + C_SDST); const float* sw = (const float*)(ws + WS_CTL + C_SW);
        bf16_t* Y = (bf16_t*)(ws + WS_Y); const int col = u.pn * 256 + wc * 32 + fq * 8;
#pragma unroll
        for (int ai = 0; ai < 2; ++ai)
#pragma unroll
            for (int m = 0; m < 4; ++m) {
                const int slot = u.slot0 + ai * HALF + wr * 64 + m * 16 + fr;
                const int dst = sdst[slot]; const float w = sw[slot];
                if (dst >= 0) {
#pragma unroll
                    for (int bj = 0; bj < 2; ++bj) { const f32x4 v0 = acc[ai][bj][m][0] * w, v1 = acc[ai][bj][m][1] * w;
                        u32x4 o; o.x = cvt_pk_bf16(v0[0], v0[1]); o.y = cvt_pk_bf16(v0[2], v0[3]); o.z = cvt_pk_bf16(v1[0], v1[1]); o.w = cvt_pk_bf16(v1[2], v1[3]);
                        *(u32x4*)(Y + (size_t)dst * DM + col + bj * HALF) = o; }
                }
            }
    }
};
struct EpiFinalF {
    static constexpr int MIDK_T = 0;
    unsigned char* ws; float* out;
    __device__ __forceinline__ void midk(pg8::f32x4 (&)[2][2][4][2], const pg8::Unit&, int, int, int, int) const {}
    __device__ __forceinline__ void operator()(const pg8::f32x4 (&acc)[2][2][4][2], const pg8::Unit& u, int wr, int wc, int fr, int fq) const {
        using namespace pg8;
        const float* H = (const float*)(ws + WS_H); const bf16_t* Y = (const bf16_t*)(ws + WS_Y);
        const int col0 = u.pn * 256 + wc * 32 + fq * 8;
#pragma unroll
        for (int ai = 0; ai < 2; ++ai)
#pragma unroll
            for (int m = 0; m < 4; ++m) {
                const int row = u.pm * BM + ai * HALF + wr * 64 + m * 16 + fr;
#pragma unroll
                for (int bj = 0; bj < 2; ++bj) {
                    const int col = col0 + bj * HALF;
                    const f32x4 h0 = *(const f32x4*)(H + (size_t)row * DM + col), h1 = *(const f32x4*)(H + (size_t)row * DM + col + 4);
                    u32x4 y[TOPK];
#pragma unroll
                    for (int k = 0; k < TOPK; ++k) y[k] = *(const u32x4*)(Y + ((size_t)row * TOPK + k) * DM + col);
                    f32x4 v0 = acc[ai][bj][m][0] + h0, v1 = acc[ai][bj][m][1] + h1;
#pragma unroll
                    for (int k = 0; k < TOPK; ++k) {
                        v0[0] += __uint_as_float(y[k].x << 16); v0[1] += __uint_as_float(y[k].x & 0xffff0000u); v0[2] += __uint_as_float(y[k].y << 16); v0[3] += __uint_as_float(y[k].y & 0xffff0000u);
                        v1[0] += __uint_as_float(y[k].z << 16); v1[1] += __uint_as_float(y[k].z & 0xffff0000u); v1[2] += __uint_as_float(y[k].w << 16); v1[3] += __uint_as_float(y[k].w & 0xffff0000u); }
                    *(f32x4*)(out + (size_t)row * DM + col) = v0; *(f32x4*)(out + (size_t)row * DM + col + 4) = v1;
                }
            }
    }
};

struct Args { In in; float* out; unsigned char* ws; int ph_lo, ph_hi; };
typedef const __attribute__((address_space(4))) Args* KArgs;
#define PHASE_KA() KArgs ka = (KArgs)__builtin_amdgcn_kernarg_segment_ptr(); asm volatile("" : "+s"(ka)); unsigned char* ws = ka->ws; F.ws = ws
__global__ void __launch_bounds__(NWAVES * 64, 2) mk_fwd(Args args) {
    extern __shared__ __attribute__((aligned(16))) unsigned char lds[];
    Frame F; F.lds = (LAS unsigned char*)lds; F.tid = threadIdx.x; F.lane = F.tid & 63; F.wave = __builtin_amdgcn_readfirstlane(F.tid >> 6);
    F.G = gridDim.x; { const int bx = blockIdx.x; F.vcu = (F.G % 8 == 0) ? (bx % 8) * (F.G / 8) + bx / 8 : bx; }
    F.ws = args.ws;
    volatile LAS unsigned* MISC = (volatile LAS unsigned*)(F.lds + MISC_OFF);
    for (int u = F.tid; u < (LDS_BYTES - LDSCTL_OFF) / 4; u += NWAVES * 64) ((LAS unsigned*)(F.lds + LDSCTL_OFF))[u] = 0u;
    __syncthreads();
    XcdBarrier bar = xcd_barrier_post((unsigned*)(args.ws + WS_CTL + C_BAR), MISC + 8);
    const int lo = args.ph_lo, hi = args.ph_hi;
#define IN(k) (lo <= (k) && (k) < hi)
#define BOTH(k) (IN(k) && IN((k) + 1))
    if (IN(0)) { PHASE_KA(); const In in = *(const In*)&ka->in; p0_prologue(F, in); p0_ssm_tables(F, in); if (BOTH(0)) xcd_barrier(bar); }
    if (IN(1)) {
        PHASE_KA();
        pg8::DenseOrder S; S.init(ws + WS_XB, (size_t)256 * DM * 2, ws + WS_WT_IN, (size_t)256 * DM * 2, T / 256, INW / 256, F.G, (int)blockIdx.x);
        EpiInProjF E{ws, ka->in.q_norm, ka->in.k_norm};
        pg8::gemm_phase<EpiInProjF, pg8::DenseOrder, false, true>(F.lds, DM, DM, DM, S, E, nullptr);
        if (BOTH(1)) xcd_barrier(bar);
    }
    if (IN(2)) {
        PHASE_KA();
        const float lam = *(const float*)(ws + WS_CTL + C_LAM); const float* subln = ka->in.subln;
        LAS float* lutl = (LAS float*)(F.lds + att::LDS_LUT);
        for (int u = F.vcu; u < NH * (T / 128); u += F.G) {
            const int h = (u >> 5) & 7, qb = (u & 31) + 32 * (u >> 8);
            const float* lutg = (const float*)(ws + WS_CTL + C_LUT) + h * LUTN;
            const float ca = lutg[LUTN - 1], cb = lutg[0];
            for (int i = F.tid; i < LUTN; i += NWAVES * 64) lutl[i] = lutg[i] - ca;
            __syncthreads();
            att::attn_unit(h, qb, (const bf16_t*)(ws + WS_Q), (const bf16_t*)(ws + WS_K), (const bf16_t*)(ws + WS_V), (bf16_t*)(ws + WS_CAT), (char*)lds, lam, subln, exp2f(cb - ca));
        }
        if (BOTH(2)) xcd_barrier(bar);
    }
    if (IN(3)) {
        PHASE_KA();
        SsmOrder S{(const char*)(ws + WS_UX), (const char*)(ws + WS_TAB + EST_OFF), (size_t)MiB, 0, 2, 1, F.G, F.vcu};
        EpiSsmS E{ws};
        pg8::gemm_phase<EpiSsmS, SsmOrder, false, true>(F.lds, 768, 512, 512, S, E, nullptr);
        if (BOTH(3)) xcd_barrier(bar);
    }
    if (IN(4)) {
        PHASE_KA(); const In in = *(const In*)&ka->in;
        const int nscan = (NG * 2 * NST) / (NWAVES * 64);
        if (F.G > nscan) { if (F.vcu < nscan) p4_scan(F, in, F.vcu * NWAVES * 64 + F.tid); else p4_expand(F, in, (F.vcu - nscan) * NWAVES * 64 + F.tid, (F.G - nscan) * NWAVES * 64); }
        else { for (int idx = F.vcu * NWAVES * 64 + F.tid; idx < NG * 2 * NST; idx += F.G * NWAVES * 64) p4_scan(F, in, idx); p4_expand(F, in, F.vcu * NWAVES * 64 + F.tid, F.G * NWAVES * 64); }
        if (BOTH(4)) xcd_barrier(bar);
    }
    if (IN(5)) {
        PHASE_KA();
        SsmOrder S{(const char*)(ws + WS_UX), (const char*)(ws + WS_TAB), (size_t)MiB, (size_t)256 * 768 * 2, 2, 2, F.G, F.vcu};
        EpiSsmY E{ws};
        pg8::gemm_phase<EpiSsmY, SsmOrder, false, true>(F.lds, 768, 768, 768, S, E, nullptr);
        if (BOTH(5)) xcd_barrier(bar);
    }
    if (IN(6)) {
        PHASE_KA();
        pg8::DenseOrder S; S.init(ws + WS_YS, (size_t)256 * SSMW * 2, ws + WS_WT_GLU, (size_t)256 * SSMW * 2, T / 256, SSMW / 256, F.G, (int)blockIdx.x);
        EpiGluF E{ws, ka->in.b_glu};
        pg8::gemm_phase<EpiGluF, pg8::DenseOrder, false, true>(F.lds, SSMW, SSMW, SSMW, S, E, nullptr);
        if (BOTH(6)) xcd_barrier(bar);
    }
    if (IN(7)) {
        PHASE_KA();
        pg8::DenseOrder S; S.init(ws + WS_CAT, (size_t)256 * DM * 2, ws + WS_WT_OUT, (size_t)256 * DM * 2, T / 256, DM / 256, F.G, (int)blockIdx.x);
        EpiOutF E{ws, ka->in.x};
        pg8::gemm_phase<EpiOutF, pg8::DenseOrder, false, true>(F.lds, DM, DM, DM, S, E, nullptr);
        if (BOTH(7)) xcd_barrier(bar);
    }
    if (IN(8)) { PHASE_KA(); const In in = *(const In*)&ka->in; p8_router(F, in); if (BOTH(8)) xcd_barrier(bar); }
    if (IN(9)) { PHASE_KA(); p9_scatter(F); if (BOTH(9)) xcd_barrier(bar); }
    if (IN(10)) {
        PHASE_KA();
        MoeOrder S; S.init((const int*)(ws + WS_CTL + C_CNT), (const int*)(ws + WS_CTL + C_OFF), ws + WS_HB, 0, ws + WS_WGU, (size_t)1024 * DM * 2, ws + WS_WT_SHGU, (size_t)256 * DM * 2, 4, F.G, F.vcu, 1);
        EpiGateUpF E{ws};
        pg8::gemm_phase<EpiGateUpF, MoeOrder, true, true>(F.lds, DM, DM, DM, S, E, (const int*)(ws + WS_CTL + C_STOK));
        if (BOTH(10)) xcd_barrier(bar);
    }
    if (IN(11)) {
        PHASE_KA();
        MoeOrder S; S.init((const int*)(ws + WS_CTL + C_CNT), (const int*)(ws + WS_CTL + C_OFF), ws + WS_H1, (size_t)EH * 2, ws + WS_WDN, (size_t)DM * EH * 2, nullptr, (size_t)256 * EH * 2, 8, F.G, F.vcu, 0);
        EpiDownF E{ws};
        pg8::gemm_phase<EpiDownF, MoeOrder, false, true>(F.lds, EH, EH, EH, S, E, nullptr);
        if (BOTH(11)) xcd_barrier(bar);
    }
    if (IN(12)) {
        PHASE_KA();
        pg8::DenseOrder S; S.init(ws + WS_HS, (size_t)256 * SH * 2, ws + WS_WT_SHD, (size_t)256 * SH * 2, T / 256, DM / 256, F.G, (int)blockIdx.x);
        EpiFinalF E{ws, ka->out};
        pg8::gemm_phase<EpiFinalF, pg8::DenseOrder, false, true>(F.lds, SH, SH, SH, S, E, nullptr);
    }
#undef IN
#undef BOTH
}

extern "C" void kernel_launch(void* const* d_in, const int* in_sizes, int n_in, void* d_out, int out_size, void* d_ws, size_t ws_size, hipStream_t stream) {
    if (n_in != 33 || ws_size < WS_END) return;
    In in; { const float** p = (const float**)&in; for (int i = 0; i < 33; ++i) p[i] = (const float*)d_in[i]; }
    unsigned char* ws = (unsigned char*)d_ws; float* out = (float*)d_out;
    const int* cnt = (const int*)(ws + WS_CTL + C_CNT); const int* off = (const int*)(ws + WS_CTL + C_OFF);
    static int grid = 0;
    if (grid == 0) {
        int dev = 0, cus = 0;
        if (hipGetDevice(&dev) != hipSuccess || hipDeviceGetAttribute(&cus, hipDeviceAttributeMultiprocessorCount, dev) != hipSuccess) { grid = -1; return; }
        if (hipFuncSetAttribute((const void*)mk_fwd, hipFuncAttributeMaxDynamicSharedMemorySize, LDS_BYTES) != hipSuccess) { grid = -1; return; }
        grid = cus;
    }
    if (grid < 0) return;
    hipMemsetAsync(ws + WS_CTL, 0, C_ZERO_BYTES, stream);
#ifndef PROBE_HI1
    { Args a{}; a.in = in; a.out = out; a.ws = ws; a.ph_lo = 0; a.ph_hi = 13; hipLaunchKernelGGL(mk_fwd, dim3(grid), dim3(NWAVES * 64), LDS_BYTES, stream, a); }
#else
    { Args a{}; a.in = in; a.out = out; a.ws = ws; a.ph_lo = 0; a.ph_hi = PROBE_HI1; hipLaunchKernelGGL(mk_fwd, dim3(grid), dim3(NWAVES * 64), LDS_BYTES, stream, a); }
    hipMemsetAsync(ws + WS_CTL, 0, C_CNT, stream);
    { Args a{}; a.in = in; a.out = out; a.ws = ws; a.ph_lo = PROBE_LO2; a.ph_hi = 13; hipLaunchKernelGGL(mk_fwd, dim3(grid), dim3(NWAVES * 64), LDS_BYTES, stream, a); }
#endif
}
```
